# Optimizing an MI355X kernel written in HIP

```python
import math
import jax
import jax.numpy as jnp
from jax import lax
import numpy as np

D_MODEL = 1024
BATCH = 2
SEQ = 8192
DEPTH = 4
DEC_BATCH = 128
DEC_SEQ = 4
PAST_LEN = 8192
PAGE_SIZE = 128

N_EVEN = (DEPTH + 1) // 2
N_ODD = DEPTH // 2
S5_WIDTH = D_MODEL // 2
S5_GROUP = 16
S5_GROUPS = S5_WIDTH // S5_GROUP
S5_STATE = 64
SWA_WIDTH = D_MODEL // 2
SWA_HEAD_DIM = 64
SWA_HEADS = SWA_WIDTH // SWA_HEAD_DIM
SWA_KV_HEADS = 2
SWA_GROUP = SWA_HEADS // SWA_KV_HEADS
WINDOW = 128
T5_BUCKETS = 32
T5_MAX_DIST = 128
HGRN_HEADS = 8
HGRN_DK = 128
HGRN_DV = D_MODEL // HGRN_HEADS
HGRN_CHUNK = 64
D_FF = 4 * D_MODEL
EVEN_IN = S5_WIDTH + SWA_WIDTH + 2 * SWA_KV_HEADS * SWA_HEAD_DIM
ODD_IN = 2 * HGRN_HEADS * HGRN_DK + 2 * HGRN_HEADS * HGRN_DV
RMS_EPS = 1e-6
NEG_INF = -1e30
LOG_FLOOR = 1e-30

kernel_name = 'hybrid_s5_swa_hgrn2_decode_step'


def rms_norm(x, w):
    xf = x.astype(jnp.float32)
    y = xf * lax.rsqrt(jnp.mean(xf * xf, axis=-1, keepdims=True) + RMS_EPS) * w.astype(jnp.float32)
    return y.astype(x.dtype)


def t5_bias(table, dist):
    n = jnp.maximum(dist, 0)
    max_exact = T5_BUCKETS // 2
    large = max_exact + (jnp.log(jnp.maximum(n, max_exact).astype(jnp.float32) / max_exact)
                         / math.log(T5_MAX_DIST / max_exact) * (T5_BUCKETS - max_exact)).astype(jnp.int32)
    large = jnp.minimum(large, T5_BUCKETS - 1)
    bucket = jnp.where(n < max_exact, n, large)
    bias = table.astype(jnp.float32)[bucket]
    return jnp.moveaxis(bias, -1, 0).reshape(SWA_KV_HEADS, SWA_GROUP, *dist.shape)


def sink_attention(q, k, v, bias, mask, sinks):
    f32 = jnp.float32
    s = jnp.einsum('bnqkgd,bnskd->bnkgqs', q.astype(f32), k.astype(f32)) * (SWA_HEAD_DIM ** -0.5)
    s = jnp.where(mask[None, :, None, None], s + bias[None, None], NEG_INF)
    sink = jnp.broadcast_to(sinks.astype(f32).reshape(SWA_KV_HEADS, SWA_GROUP)[None, None, :, :, None, None],
                            s.shape[:-1] + (1,))
    p = jax.nn.softmax(jnp.concatenate([s, sink], axis=-1), axis=-1)[..., :-1]
    return jnp.einsum('bnkgqs,bnskd->bnqkgd', p, v.astype(f32))


def swa_prompt(q, k, v, sinks, table):
    bt, L, _ = q.shape
    nb = L // WINDOW
    qb = q.reshape(bt, nb, WINDOW, SWA_KV_HEADS, SWA_GROUP, SWA_HEAD_DIM)
    kb = k.reshape(bt, nb, WINDOW, SWA_KV_HEADS, SWA_HEAD_DIM)
    vb = v.reshape(bt, nb, WINDOW, SWA_KV_HEADS, SWA_HEAD_DIM)

    def band(t):
        prev = jnp.concatenate([jnp.zeros_like(t[:, :1]), t[:, :-1]], axis=1)
        return jnp.concatenate([prev, t], axis=2)

    t_idx = jnp.arange(WINDOW)[:, None]
    m_idx = jnp.arange(2 * WINDOW)[None, :]
    dist = WINDOW + t_idx - m_idx
    in_win = (dist >= 0) & (dist < WINDOW)
    blk = jnp.arange(nb)[:, None, None]
    mask = in_win[None] & ((blk > 0) | (m_idx[None] >= WINDOW))
    o = sink_attention(qb, band(kb), band(vb), t5_bias(table, dist), mask, sinks)
    w = min(WINDOW, L)
    return o.reshape(bt, L, SWA_HEADS * SWA_HEAD_DIM), k[:, L - w:], v[:, L - w:]


def swa_sample(q, k, v, cache_k, cache_v, sinks, table):
    bt, L, _ = q.shape
    wc = cache_k.shape[1]
    kk = jnp.concatenate([cache_k, k.astype(cache_k.dtype)], axis=1)
    vv = jnp.concatenate([cache_v, v.astype(cache_v.dtype)], axis=1)
    dist = wc + jnp.arange(L)[:, None] - jnp.arange(wc + L)[None, :]
    mask = ((dist >= 0) & (dist < WINDOW))[None]
    qb = q.reshape(bt, 1, L, SWA_KV_HEADS, SWA_GROUP, SWA_HEAD_DIM)
    o = sink_attention(qb, kk[:, None], vv[:, None], t5_bias(table, dist), mask, sinks)
    return o.reshape(bt, L, SWA_HEADS * SWA_HEAD_DIM), kk[:, L:], vv[:, L:]


def s5_mixer(u, h0_re, h0_im, lam_re, lam_im, log_step, b_re, b_im, c_re, c_im, d_skip, w_glu):
    f32 = jnp.float32
    bt, L, _ = u.shape
    uf = u.astype(f32)
    ug = uf.reshape(bt, L, S5_GROUPS, S5_GROUP)
    lam_re = lam_re.astype(f32)
    lam_im = lam_im.astype(f32)
    dt = jnp.exp(log_step.astype(f32))[:, None]
    mag = jnp.exp(lam_re * dt)
    ang = lam_im * dt
    abar_re = mag * jnp.cos(ang)
    abar_im = mag * jnp.sin(ang)
    den = lam_re * lam_re + lam_im * lam_im
    nr = abar_re - 1.0
    coef_re = ((nr * lam_re + abar_im * lam_im) / den)[..., None]
    coef_im = ((abar_im * lam_re - nr * lam_im) / den)[..., None]
    b_re = b_re.astype(f32)
    b_im = b_im.astype(f32)
    bb_re = coef_re * b_re - coef_im * b_im
    bb_im = coef_re * b_im + coef_im * b_re
    bu_re = jnp.einsum('blgc,gpc->blgp', ug, bb_re)
    bu_im = jnp.einsum('blgc,gpc->blgp', ug, bb_im)
    h0_re = h0_re.astype(f32)
    h0_im = h0_im.astype(f32)
    bu_re = bu_re.at[:, 0].add(abar_re * h0_re - abar_im * h0_im)
    bu_im = bu_im.at[:, 0].add(abar_re * h0_im + abar_im * h0_re)
    a_re = jnp.broadcast_to(abar_re, bu_re.shape)
    a_im = jnp.broadcast_to(abar_im, bu_im.shape)

    def combine(e1, e2):
        a1r, a1i, b1r, b1i = e1
        a2r, a2i, b2r, b2i = e2
        return (a1r * a2r - a1i * a2i, a1r * a2i + a1i * a2r,
                a2r * b1r - a2i * b1i + b2r, a2r * b1i + a2i * b1r + b2i)

    _, _, h_re, h_im = lax.associative_scan(combine, (a_re, a_im, bu_re, bu_im), axis=1)
    y = (jnp.einsum('gcp,blgp->blgc', c_re.astype(f32), h_re)
         - jnp.einsum('gcp,blgp->blgc', c_im.astype(f32), h_im)).reshape(bt, L, S5_WIDTH)
    y = y + d_skip.astype(f32) * uf
    g = jax.nn.gelu(y)
    out = g * jax.nn.sigmoid(g @ w_glu.astype(f32))
    return out.astype(u.dtype), h_re[:, -1], h_im[:, -1]


def hgrn2_mixer(q, fz, iv, gz, lb, s0, gnorm_w):
    f32 = jnp.float32
    bt, L, _ = q.shape
    lb = lb.astype(f32)
    fzf = fz.astype(f32)
    qf = jax.nn.silu(q.astype(f32))
    log_f = jnp.logaddexp(jnp.log(jnp.maximum(lb, LOG_FLOOR)), jnp.log1p(-lb) + jax.nn.log_sigmoid(fzf))
    kf = (1.0 - lb) * jax.nn.sigmoid(-fzf)
    vf = iv.astype(f32)
    c = min(HGRN_CHUNK, L)
    nc = -(-L // c)
    pad = nc * c - L

    def chunked(t, dim):
        t = t.reshape(bt, L, HGRN_HEADS, dim)
        t = jnp.pad(t, ((0, 0), (0, pad), (0, 0), (0, 0)))
        return jnp.moveaxis(t.reshape(bt, nc, c, HGRN_HEADS, dim), 1, 0)

    xs = (chunked(qf, HGRN_DK), chunked(kf, HGRN_DK), chunked(log_f, HGRN_DK), chunked(vf, HGRN_DV))
    causal = jnp.tril(jnp.ones((c, c), dtype=bool))[None, :, :, None, None]

    def step(S, inp):
        qc, kc, gc, vc = inp
        b = jnp.cumsum(gc, axis=1)
        diff = b[:, :, None] - b[:, None, :]
        decay = jnp.exp(jnp.where(causal, diff, NEG_INF))
        scores = jnp.einsum('bthd,bshd,btshd->bhts', qc, kc, decay)
        o = (jnp.einsum('bhts,bshv->bthv', scores, vc)
             + jnp.einsum('bthd,bhdv->bthv', qc * jnp.exp(b), S))
        b_last = b[:, -1]
        S = (jnp.exp(b_last)[..., None] * S
             + jnp.einsum('bshd,bshv->bhdv', kc * jnp.exp(b_last[:, None] - b), vc))
        return S, o

    s_fin, o = lax.scan(step, s0.astype(f32), xs)
    o = jnp.moveaxis(o, 0, 1).reshape(bt, nc * c, HGRN_HEADS, HGRN_DV)[:, :L]
    o = o * lax.rsqrt(jnp.mean(o * o, axis=-1, keepdims=True) + RMS_EPS) * gnorm_w.astype(f32)
    o = o * jax.nn.silu(gz.astype(f32).reshape(bt, L, HGRN_HEADS, HGRN_DV))
    return o.reshape(bt, L, HGRN_HEADS * HGRN_DV).astype(q.dtype), s_fin


def trunk(x, cache_k, cache_v, st_re, st_im, st_h, p):
    prompt = cache_k is None
    bt, L, _ = x.shape
    sm = jax.nn.softmax(p['hgrn_lb_param'].astype(jnp.float32), axis=0)
    lower_bounds = jnp.cumsum(sm, axis=0) - sm[0]
    k_out, v_out, re_out, im_out, h_out = [], [], [], [], []
    split_even = [S5_WIDTH, S5_WIDTH + SWA_WIDTH, S5_WIDTH + SWA_WIDTH + SWA_KV_HEADS * SWA_HEAD_DIM]
    qk_w = HGRN_HEADS * HGRN_DK
    split_odd = [qk_w, 2 * qk_w, 2 * qk_w + HGRN_HEADS * HGRN_DV]
    for layer in range(DEPTH):
        idx = layer // 2
        h = rms_norm(x, p['norm_mix_pre'][layer])
        if layer % 2 == 0:
            proj = h @ p['w_in_even'][idx]
            u, q, k, v = jnp.split(proj, split_even, axis=-1)
            if prompt:
                h0_re = jnp.zeros((bt, S5_GROUPS, S5_STATE), jnp.float32)
                h0_im = jnp.zeros((bt, S5_GROUPS, S5_STATE), jnp.float32)
            else:
                h0_re, h0_im = st_re[idx], st_im[idx]
            a_out, h_re, h_im = s5_mixer(u, h0_re, h0_im, p['s5_lambda_re'][idx], p['s5_lambda_im'][idx],
                                         p['s5_log_step'][idx], p['s5_b_re'][idx], p['s5_b_im'][idx],
                                         p['s5_c_re'][idx], p['s5_c_im'][idx], p['s5_d'][idx],
                                         p['s5_w_glu'][idx])
            k = k.reshape(bt, L, SWA_KV_HEADS, SWA_HEAD_DIM)
            v = v.reshape(bt, L, SWA_KV_HEADS, SWA_HEAD_DIM)
            if prompt:
                b_out, kw, vw = swa_prompt(q, k, v, p['swa_sinks'][idx], p['t5_bias_table'])
            else:
                b_out, kw, vw = swa_sample(q, k, v, cache_k[idx], cache_v[idx],
                                           p['swa_sinks'][idx], p['t5_bias_table'])
            mix = jnp.concatenate([a_out, b_out.astype(a_out.dtype)], axis=-1) @ p['w_out_even'][idx]
            k_out.append(kw)
            v_out.append(vw)
            re_out.append(h_re.astype(x.dtype))
            im_out.append(h_im.astype(x.dtype))
        else:
            proj = h @ p['w_in_odd'][idx]
            q, fz, iv, gz = jnp.split(proj, split_odd, axis=-1)
            if prompt:
                s0 = jnp.zeros((bt, HGRN_HEADS, HGRN_DK, HGRN_DV), jnp.float32)
            else:
                s0 = st_h[idx]
            c_out, s_new = hgrn2_mixer(q, fz, iv, gz, lower_bounds[idx], s0, p['hgrn_gnorm'][idx])
            mix = c_out @ p['w_out_odd'][idx]
            h_out.append(s_new.astype(x.dtype))
        x = x + rms_norm(mix, p['norm_mix_post'][layer])
        h = rms_norm(x, p['norm_mlp_pre'][layer])
        h = jnp.square(jax.nn.relu(h @ p['w_up'][layer])) @ p['w_down'][layer]
        x = x + rms_norm(h, p['norm_mlp_post'][layer])
    return x, jnp.stack(k_out), jnp.stack(v_out), jnp.stack(re_out), jnp.stack(im_out), jnp.stack(h_out)


def setup_inputs(seed: int = 0) -> dict:
    key = jax.random.key(seed)
    keys = iter(jax.random.split(key, 40))
    f32 = jnp.float32

    def normal(shape, scale):
        return jax.random.normal(next(keys), shape, f32) * scale

    def gain(shape):
        return 1.0 + normal(shape, 0.02)

    sw = min(WINDOW, PAST_LEN)
    n_idx = jnp.arange(S5_STATE, dtype=f32)
    mix_w = S5_WIDTH + SWA_WIDTH
    return {
        'x_prompt': normal((BATCH, SEQ, D_MODEL), 1.0),
        'x_sample': normal((DEC_BATCH, DEC_SEQ, D_MODEL), 1.0),
        'cache_swa_k': normal((N_EVEN, DEC_BATCH, sw, SWA_KV_HEADS, SWA_HEAD_DIM), 1.0),
        'cache_swa_v': normal((N_EVEN, DEC_BATCH, sw, SWA_KV_HEADS, SWA_HEAD_DIM), 1.0),
        'state_s5_re': normal((N_EVEN, DEC_BATCH, S5_GROUPS, S5_STATE), 0.5),
        'state_s5_im': normal((N_EVEN, DEC_BATCH, S5_GROUPS, S5_STATE), 0.5),
        'state_hgrn': normal((N_ODD, DEC_BATCH, HGRN_HEADS, HGRN_DK, HGRN_DV), 0.5),
        't5_bias_table': normal((T5_BUCKETS, SWA_HEADS), 0.5),
        'norm_mix_pre': gain((DEPTH, D_MODEL)),
        'norm_mix_post': gain((DEPTH, D_MODEL)),
        'norm_mlp_pre': gain((DEPTH, D_MODEL)),
        'norm_mlp_post': gain((DEPTH, D_MODEL)),
        'w_in_even': normal((N_EVEN, D_MODEL, EVEN_IN), D_MODEL ** -0.5),
        'w_out_even': normal((N_EVEN, mix_w, D_MODEL), mix_w ** -0.5),
        's5_lambda_re': -0.5 + normal((N_EVEN, S5_GROUPS, S5_STATE), 0.01),
        's5_lambda_im': math.pi * n_idx + normal((N_EVEN, S5_GROUPS, S5_STATE), 0.01),
        's5_log_step': jax.random.uniform(next(keys), (N_EVEN, S5_GROUPS), f32,
                                          math.log(1e-3), math.log(1e-1)),
        's5_b_re': normal((N_EVEN, S5_GROUPS, S5_STATE, S5_GROUP), (2 * S5_GROUP) ** -0.5),
        's5_b_im': normal((N_EVEN, S5_GROUPS, S5_STATE, S5_GROUP), (2 * S5_GROUP) ** -0.5),
        's5_c_re': normal((N_EVEN, S5_GROUPS, S5_GROUP, S5_STATE), (2 * S5_STATE) ** -0.5),
        's5_c_im': normal((N_EVEN, S5_GROUPS, S5_GROUP, S5_STATE), (2 * S5_STATE) ** -0.5),
        's5_d': normal((N_EVEN, S5_WIDTH), 1.0),
        's5_w_glu': normal((N_EVEN, S5_WIDTH, S5_WIDTH), S5_WIDTH ** -0.5),
        'swa_sinks': normal((N_EVEN, SWA_HEADS), 0.5),
        'w_in_odd': normal((N_ODD, D_MODEL, ODD_IN), D_MODEL ** -0.5),
        'w_out_odd': normal((N_ODD, HGRN_HEADS * HGRN_DV, D_MODEL), (HGRN_HEADS * HGRN_DV) ** -0.5),
        'hgrn_lb_param': normal((N_ODD, HGRN_HEADS * HGRN_DK), 1.0),
        'hgrn_gnorm': gain((N_ODD, HGRN_DV)),
        'w_up': normal((DEPTH, D_MODEL, D_FF), D_MODEL ** -0.5),
        'w_down': normal((DEPTH, D_FF, D_MODEL), D_FF ** -0.5),
    }


def reference(x_prompt, x_sample, cache_swa_k, cache_swa_v, state_s5_re, state_s5_im, state_hgrn,
              t5_bias_table, norm_mix_pre, norm_mix_post, norm_mlp_pre, norm_mlp_post,
              w_in_even, w_out_even, s5_lambda_re, s5_lambda_im, s5_log_step, s5_b_re, s5_b_im,
              s5_c_re, s5_c_im, s5_d, s5_w_glu, swa_sinks, w_in_odd, w_out_odd, hgrn_lb_param,
              hgrn_gnorm, w_up, w_down):
    params = dict(t5_bias_table=t5_bias_table, norm_mix_pre=norm_mix_pre, norm_mix_post=norm_mix_post,
                  norm_mlp_pre=norm_mlp_pre, norm_mlp_post=norm_mlp_post, w_in_even=w_in_even,
                  w_out_even=w_out_even, s5_lambda_re=s5_lambda_re, s5_lambda_im=s5_lambda_im,
                  s5_log_step=s5_log_step, s5_b_re=s5_b_re, s5_b_im=s5_b_im, s5_c_re=s5_c_re,
                  s5_c_im=s5_c_im, s5_d=s5_d, s5_w_glu=s5_w_glu, swa_sinks=swa_sinks,
                  w_in_odd=w_in_odd, w_out_odd=w_out_odd, hgrn_lb_param=hgrn_lb_param,
                  hgrn_gnorm=hgrn_gnorm, w_up=w_up, w_down=w_down)
    y_prompt, k_p, v_p, re_p, im_p, hg_p = trunk(x_prompt, None, None, None, None, None, params)
    y_sample, k_s, v_s, re_s, im_s, hg_s = trunk(x_sample, cache_swa_k, cache_swa_v, state_s5_re,
                                                 state_s5_im, state_hgrn, params)
    return (y_prompt, y_sample, k_p, v_p, k_s, v_s, re_p, im_p, re_s, im_s, hg_p, hg_s)
```

```cpp
#include <hip/hip_runtime.h>
#include <cstdio>
#include <cstdint>

constexpr int DM = 1024, SEQ = 8192, NB = 2, TP = NB * SEQ, DECB = 128, DECL = 4, TS = DECB * DECL, MT = TP + TS;
constexpr int EVEN_IN = 1280, ODD_IN = 4096, DFF = 4096;
constexpr int S5G = 32, S5C = 16, S5P = 64, S5W = 512;
constexpr int SWH = 8, SWKV = 2, SWG = 4, SWD = 64, WIN = 128;
constexpr int HH = 8, HDK = 128, HDV = 128, HCH = 64;
constexpr float RMS_EPS = 1e-6f;
constexpr size_t O_Y = 0, O_KP = (size_t)MT * DM, O_VP = O_KP + 65536, O_KS = O_VP + 65536, O_VS = O_KS + 4194304, O_REP = O_VS + 4194304, O_IMP = O_REP + 8192,
                 O_RES = O_IMP + 8192, O_IMS = O_RES + 524288, O_HP = O_IMS + 524288, O_HS = O_HP + 524288, O_END = O_HS + 33554432;
enum { I_XP = 0, I_XS, I_CK, I_CV, I_SRE, I_SIM, I_SH, I_T5, I_NMIXPRE, I_NMIXPOST, I_NMLPPRE, I_NMLPPOST, I_WINE, I_WOUTE, I_LRE, I_LIM, I_LSTEP, I_BRE, I_BIM, I_CRE, I_CIM, I_S5D, I_WGLU,
       I_SINK, I_WINO, I_WOUTO, I_LB, I_GN, I_WUP, I_WDN, N_IN };
constexpr size_t MiB = 1u << 20;
constexpr size_t WS_CTL = 0, CTL_ZERO_BYTES = 1 * MiB;
constexpr size_t WS_WINE = 2 * MiB, WS_WOUTE = 7 * MiB, WS_WGLU = 11 * MiB, WS_WINO = 12 * MiB, WS_WOUTO = 28 * MiB, WS_WUP = 32 * MiB, WS_WDN = 64 * MiB;
constexpr size_t WS_XN = 96 * MiB, WS_CAT = 129 * MiB, WS_G = 162 * MiB, WS_PROJ = 179 * MiB, WS_MIX = 311 * MiB, WS_S5E = 377 * MiB, WS_HU = 379 * MiB, WS_HS = 411 * MiB, WS_HD = 443 * MiB, WS_END = 444 * MiB;
constexpr int NSC = 32, SCT = SEQ / NSC;

#define GAS __attribute__((address_space(1)))
#define LAS __attribute__((address_space(3)))
typedef unsigned short bf16;
typedef unsigned v4u __attribute__((ext_vector_type(4)));
typedef unsigned v2u __attribute__((ext_vector_type(2)));
typedef float f32x4 __attribute__((ext_vector_type(4)));
typedef float f32x16 __attribute__((ext_vector_type(16)));
typedef short bf16x8 __attribute__((ext_vector_type(8)));
typedef short s16x4 __attribute__((ext_vector_type(4)));
__device__ __forceinline__ unsigned f2bf(float f) { unsigned u = __builtin_bit_cast(unsigned, f); return (u + 0x7fffu + ((u >> 16) & 1u)) >> 16; }
__device__ __forceinline__ unsigned pk2(float lo, float hi) { return f2bf(lo) | (f2bf(hi) << 16); }
__device__ __forceinline__ float bflo(unsigned w) { return __builtin_bit_cast(float, w << 16); }
__device__ __forceinline__ float bfhi(unsigned w) { return __builtin_bit_cast(float, w & 0xffff0000u); }
__device__ __forceinline__ float bf2f(bf16 h) { return __builtin_bit_cast(float, (unsigned)h << 16); }
__device__ __forceinline__ float wave_sum(float v) {
#pragma unroll
    for (int o = 1; o < 64; o <<= 1) v += __shfl_xor(v, o);
    return v;
}
__device__ __forceinline__ float sigmoidf_(float x) { return 1.0f / (1.0f + __expf(-x)); }
namespace pg8 {
#define PG8_LAS __attribute__((address_space(3)))
typedef unsigned short bf16_t;
typedef short bf16x8 __attribute__((ext_vector_type(8)));
typedef float f32x4 __attribute__((ext_vector_type(4)));
typedef unsigned u32x4 __attribute__((ext_vector_type(4)));
constexpr int BM = 256, BK = 64, HALF = 128, HTB = HALF * BK * 2  , STAGE_BYTES = 8 * HTB, NXCD = 8, WGM = 8;

__host__ __device__ __forceinline__ int lds_byte(int r, int c) { const int st = (r >> 4) * 2 + (c >> 5), rr = r & 15, cc = c & 31, ob = rr * 64 + cc * 2; return st * 1024 + (ob ^ (((ob >> 9) & 1) << 5)); }
__host__ __device__ __forceinline__ void stage_rc(int b, int& R, int& C) { const int st = b / 1024, sb = b % 1024, swz = sb ^ (((sb >> 9) & 1) << 5); R = (st >> 1) * 16 + swz / 64; C = (st & 1) * 32 + (swz % 64) / 2; }
__host__ __device__ __forceinline__ int perm32(int rho) { const int n = rho >> 4, i = rho & 15; return 8 * (i >> 2) + 4 * n + (i & 3); }

struct Unit { int pm, pn; };
struct Gemm { const bf16_t* A; const bf16_t* Bt; int M, N, K; };

struct StaticOrder {
    int nM, nN, nwg, G, c;
    __host__ __device__ void init(int M, int N, int G_, int c_) { nM = M / BM; nN = N / BM; nwg = nM * nN; G = G_; c = c_; }
    __host__ __device__ bool next(int i, Unit& u) const {
        const long L = (long)i * G + c; if (L >= nwg) return false;
        int wgid = (int)L; { const int q = nwg / NXCD, r = nwg % NXCD, xcd = wgid % NXCD, off = wgid / NXCD; wgid = (xcd < r ? xcd * (q + 1) : r * (q + 1) + (xcd - r) * q) + off; }
        const int nig = WGM * nN, gid = wgid / nig, fm = gid * WGM, gsz = (nM - fm) < WGM ? (nM - fm) : WGM;
        u.pm = fm + ((wgid % nig) % gsz); u.pn = (wgid % nig) / gsz; return true;
    }
    __device__ __forceinline__ void a_ready(const Unit&) const {}
    __device__ __forceinline__ void done(const Unit&) const {}
};

__device__ __forceinline__ unsigned cvt_pk_bf16(float lo, float hi) { unsigned r; asm volatile("v_cvt_pk_bf16_f32 %0, %1, %2" : "=v"(r) : "v"(lo), "v"(hi)); return r; }
struct EpiF32 {
    static constexpr bool PERM = false, AFTER_DRAIN = false;
    float* C; int ldc;
    __device__ __forceinline__ void operator()(const f32x4 (&acc)[2][2][4][2], const Unit& u, int wr, int wc, int fr, int fq) const {
        const int row0 = u.pm * BM + wr * 64 + fr, col0 = u.pn * BM + wc * 32 + 4 * fq;
#pragma unroll
        for (int ai = 0; ai < 2; ++ai)
#pragma unroll
            for (int m = 0; m < 4; ++m) { float* rowp = C + (size_t)(row0 + ai * HALF + m * 16) * ldc + col0;
#pragma unroll
                for (int bj = 0; bj < 2; ++bj)
#pragma unroll
                    for (int n = 0; n < 2; ++n) *(f32x4*)(rowp + bj * HALF + n * 16) = acc[ai][bj][m][n]; }
    }
};
template <int ACT  > struct EpiBf16 {
    static constexpr bool PERM = true, AFTER_DRAIN = false;
    bf16_t* O; int ldc;
    __device__ __forceinline__ void operator()(const f32x4 (&acc)[2][2][4][2], const Unit& u, int wr, int wc, int fr, int fq) const {
        const int row0 = u.pm * BM + wr * 64 + fr; const int col0 = u.pn * BM + wc * 32 + 8 * fq;
#pragma unroll
        for (int ai = 0; ai < 2; ++ai)
#pragma unroll
            for (int m = 0; m < 4; ++m) { bf16_t* rowp = O + (size_t)(row0 + ai * HALF + m * 16) * ldc + col0;
#pragma unroll
                for (int bj = 0; bj < 2; ++bj) { f32x4 v0 = acc[ai][bj][m][0], v1 = acc[ai][bj][m][1];
                    if (ACT == 2) {
#pragma unroll
                        for (int e = 0; e < 4; ++e) { const float a = v0[e] > 0.f ? v0[e] : 0.f, b = v1[e] > 0.f ? v1[e] : 0.f; v0[e] = a * a; v1[e] = b * b; } }
                    u32x4 w; w.x = cvt_pk_bf16(v0[0], v0[1]); w.y = cvt_pk_bf16(v0[2], v0[3]); w.z = cvt_pk_bf16(v1[0], v1[1]); w.w = cvt_pk_bf16(v1[2], v1[3]);
                    *(u32x4*)(rowp + bj * HALF) = w; } }
    }
};
struct EpiGlu {
    static constexpr bool PERM = true, AFTER_DRAIN = false;
    const bf16_t* Gm; int ldg; bf16_t* O; int ldc;
    __device__ __forceinline__ void operator()(const f32x4 (&acc)[2][2][4][2], const Unit& u, int wr, int wc, int fr, int fq) const {
        const int row0 = u.pm * BM + wr * 64 + fr; const int col0 = u.pn * BM + wc * 32 + 8 * fq;
#pragma unroll
        for (int ai = 0; ai < 2; ++ai)
#pragma unroll
            for (int m = 0; m < 4; ++m) { const size_t row = (size_t)(row0 + ai * HALF + m * 16);
#pragma unroll
                for (int bj = 0; bj < 2; ++bj) { const f32x4 v0 = acc[ai][bj][m][0], v1 = acc[ai][bj][m][1];
                    const u32x4 gw = *(const u32x4*)(Gm + row * ldg + col0 + bj * HALF);
                    float gv[8]; gv[0] = __builtin_bit_cast(float, gw.x << 16); gv[1] = __builtin_bit_cast(float, gw.x & 0xffff0000u); gv[2] = __builtin_bit_cast(float, gw.y << 16); gv[3] = __builtin_bit_cast(float, gw.y & 0xffff0000u);
                    gv[4] = __builtin_bit_cast(float, gw.z << 16); gv[5] = __builtin_bit_cast(float, gw.z & 0xffff0000u); gv[6] = __builtin_bit_cast(float, gw.w << 16); gv[7] = __builtin_bit_cast(float, gw.w & 0xffff0000u);
                    float o[8];
#pragma unroll
                    for (int e = 0; e < 4; ++e) { o[e] = gv[e] / (1.0f + __expf(-v0[e])); o[4 + e] = gv[4 + e] / (1.0f + __expf(-v1[e])); }
                    u32x4 w; w.x = cvt_pk_bf16(o[0], o[1]); w.y = cvt_pk_bf16(o[2], o[3]); w.z = cvt_pk_bf16(o[4], o[5]); w.w = cvt_pk_bf16(o[6], o[7]);
                    *(u32x4*)(O + row * ldc + col0 + bj * HALF) = w; } }
    }
};
template <class Epi, class Sched, bool ALIGN_EPI = false, bool SP2 = false>
__device__ __forceinline__ void gemm_phase(PG8_LAS unsigned char* lds, const Gemm g, const Sched& S, const Epi& E) {
    int tid_ = threadIdx.x; asm volatile("" : "+v"(tid_));
    const int tid = tid_, wid = __builtin_amdgcn_readfirstlane(tid >> 6), lane = tid & 63, wr = wid >> 2, wc = wid & 3, fr = lane & 15, fq = lane >> 4;
    const int K = g.K, nt = K / BK;
    unsigned voffA[2], voffB[2];
#pragma unroll
    for (int i = 0; i < 2; ++i) { int R, C; stage_rc(tid * 16 + i * 8192, R, C); const int Rb = Epi::PERM ? ((R & ~31) + perm32(R & 31)) : R;
        voffA[i] = (unsigned)(R * K + C) * 2u; voffB[i] = (unsigned)(Rb * K + C) * 2u; }
    const size_t kstep = (size_t)(BK * 2);
    const size_t hstep = (size_t)HALF * K * 2;
    const size_t tstep = 2 * hstep;
    const unsigned ldsw = (unsigned)wid * 1024u;
    const int aoff = lds_byte(wr * 64 + fr, fq * 8), boff = lds_byte(wc * 32 + fr, fq * 8);
#define PG8_SA(b, h) (((b) * 2 + (h)) * HTB)
#define PG8_SB(b, h) ((4 + (b) * 2 + (h)) * HTB)
#define PG8_STAGE(bufoff, gbase, voff) do { _Pragma("unroll") for (int _i = 0; _i < 2; ++_i) \
        __builtin_amdgcn_global_load_lds((const unsigned*)((const char*)(gbase) + (voff)[_i]), (PG8_LAS unsigned*)(lds + (bufoff) + ldsw + _i * 8192), 16, 0, 0); } while (0)
#define PG8_LDA(dst, b, h) do { _Pragma("unroll") for (int m = 0; m < 4; ++m) _Pragma("unroll") for (int k = 0; k < 2; ++k) dst[m][k] = *(const PG8_LAS bf16x8*)(lds + PG8_SA(b, h) + aoff + m * 2048 + k * 1024); } while (0)
#define PG8_LDB(dst, b, h) do { _Pragma("unroll") for (int n = 0; n < 2; ++n) _Pragma("unroll") for (int k = 0; k < 2; ++k) dst[n][k] = *(const PG8_LAS bf16x8*)(lds + PG8_SB(b, h) + boff + n * 2048 + k * 1024); } while (0)
#define PG8_MMA(ai, bj, At, Bt) do { __builtin_amdgcn_s_setprio(1); _Pragma("unroll") for (int m = 0; m < 4; ++m) _Pragma("unroll") for (int n = 0; n < 2; ++n) _Pragma("unroll") for (int k = 0; k < 2; ++k) \
        acc[ai][bj][m][n] = __builtin_amdgcn_mfma_f32_16x16x32_bf16(Bt[n][k], At[m][k], acc[ai][bj][m][n], 0, 0, 0); __builtin_amdgcn_s_setprio(0); } while (0)
#define PG8_WAIT_V(n) asm volatile("s_waitcnt vmcnt(" #n ")" ::: "memory")
#define PG8_WAIT_L(n) asm volatile("s_waitcnt lgkmcnt(" #n ")" ::: "memory")
#define PG8_BAR __builtin_amdgcn_s_barrier()
#define PG8_SCHED __builtin_amdgcn_sched_barrier(0)
    Unit cur, nxt; int ui = 0;
    if (!S.next(0, cur)) return;
    f32x4 acc[2][2][4][2];
#pragma unroll
    for (int a = 0; a < 2; ++a)
#pragma unroll
        for (int b = 0; b < 2; ++b)
#pragma unroll
            for (int m = 0; m < 4; ++m)
#pragma unroll
                for (int n = 0; n < 2; ++n) acc[a][b][m][n] = (f32x4){0.f, 0.f, 0.f, 0.f};
    bf16x8 At[4][2], B0[2][2], B1[2][2];
    const char* cA = (const char*)g.A + (size_t)cur.pm * tstep; const char* cB = (const char*)g.Bt + (size_t)cur.pn * tstep;
    S.a_ready(cur);
    if constexpr (SP2) {
        PG8_STAGE(PG8_SB(0, 0), cB, voffB); PG8_STAGE(PG8_SB(0, 1), cB + hstep, voffB); PG8_STAGE(PG8_SA(0, 0), cA, voffA); PG8_STAGE(PG8_SA(0, 1), cA + hstep, voffA);
        if (wr == 1) PG8_BAR;
        PG8_WAIT_V(2); PG8_BAR;
        PG8_STAGE(PG8_SB(1, 0), cB + kstep, voffB); PG8_STAGE(PG8_SA(1, 0), cA + kstep, voffA); PG8_STAGE(PG8_SB(1, 1), cB + hstep + kstep, voffB);
        PG8_WAIT_V(6); PG8_BAR;
    } else {
        PG8_STAGE(PG8_SB(0, 0), cB, voffB); PG8_STAGE(PG8_SA(0, 0), cA, voffA); PG8_STAGE(PG8_SB(0, 1), cB + hstep, voffB); PG8_STAGE(PG8_SA(0, 1), cA + hstep, voffA);
        if (wr == 1) PG8_BAR;
        PG8_WAIT_V(4); PG8_BAR;
        PG8_STAGE(PG8_SB(1, 0), cB + kstep, voffB); PG8_STAGE(PG8_SA(1, 0), cA + kstep, voffA); PG8_STAGE(PG8_SB(1, 1), cB + hstep + kstep, voffB);
        PG8_WAIT_V(6); PG8_BAR;
    }
    for (;;) {
        const bool has_next = S.next(ui + 1, nxt);
        const char* nA = has_next ? (const char*)g.A + (size_t)nxt.pm * tstep : cA; const char* nB = has_next ? (const char*)g.Bt + (size_t)nxt.pn * tstep : cB;
        for (int t = 0; t < nt; t += 2) {
            const bool last = (t == nt - 2);
            const char* a1 = cA + (size_t)(t + 1) * kstep;
            const char* a2 = last ? nA : cA + (size_t)(t + 2) * kstep; const char* b2 = last ? nB : cB + (size_t)(t + 2) * kstep;
            const char* a3 = a2 + kstep; const char* b3 = b2 + kstep;
            if (last && has_next) S.a_ready(nxt);
            if constexpr (SP2) {
            PG8_LDB(B0, 0, 0); PG8_LDB(B1, 0, 1); PG8_SCHED; PG8_LDA(At, 0, 0); PG8_STAGE(PG8_SA(1, 1), a1 + hstep, voffA);
            PG8_WAIT_V(8); PG8_WAIT_L(0); PG8_BAR; PG8_MMA(0, 0, At, B0); PG8_MMA(0, 1, At, B1); PG8_BAR; PG8_SCHED;
            PG8_LDA(At, 0, 1); PG8_STAGE(PG8_SB(0, 0), b2, voffB); PG8_STAGE(PG8_SB(0, 1), b2 + hstep, voffB); PG8_STAGE(PG8_SA(0, 0), a2, voffA);
            PG8_WAIT_V(8); PG8_WAIT_L(0); PG8_BAR; PG8_MMA(1, 0, At, B0); PG8_MMA(1, 1, At, B1); PG8_BAR; PG8_SCHED;
            PG8_LDB(B0, 1, 0); PG8_LDB(B1, 1, 1); PG8_SCHED; PG8_LDA(At, 1, 0); PG8_STAGE(PG8_SA(0, 1), a2 + hstep, voffA);
            PG8_WAIT_V(8); PG8_WAIT_L(0); PG8_BAR; PG8_MMA(0, 0, At, B0); PG8_MMA(0, 1, At, B1); PG8_BAR; PG8_SCHED;
            PG8_LDA(At, 1, 1); PG8_STAGE(PG8_SB(1, 0), b3, voffB); PG8_STAGE(PG8_SB(1, 1), b3 + hstep, voffB); PG8_STAGE(PG8_SA(1, 0), a3, voffA);
            PG8_WAIT_V(8); PG8_WAIT_L(0); PG8_BAR; PG8_MMA(1, 0, At, B0); PG8_MMA(1, 1, At, B1); PG8_BAR; PG8_SCHED;
            } else {
            PG8_LDB(B0, 0, 0); PG8_SCHED; PG8_LDA(At, 0, 0); PG8_STAGE(PG8_SA(1, 1), a1 + hstep, voffA);
            PG8_WAIT_L(8); PG8_BAR; PG8_WAIT_L(0); PG8_MMA(0, 0, At, B0); PG8_BAR; PG8_SCHED;
            PG8_LDB(B1, 0, 1); PG8_STAGE(PG8_SB(0, 0), b2, voffB);
            PG8_BAR; PG8_WAIT_L(0); PG8_MMA(0, 1, At, B1); PG8_BAR;
            PG8_LDA(At, 0, 1); PG8_STAGE(PG8_SA(0, 0), a2, voffA);
            PG8_BAR; PG8_WAIT_L(0); PG8_MMA(1, 0, At, B0); PG8_BAR; PG8_SCHED;
            PG8_STAGE(PG8_SB(0, 1), b2 + hstep, voffB);
            PG8_WAIT_V(6); PG8_BAR; PG8_MMA(1, 1, At, B1); PG8_BAR;
            PG8_LDB(B0, 1, 0); PG8_SCHED; PG8_LDA(At, 1, 0); PG8_STAGE(PG8_SA(0, 1), a2 + hstep, voffA);
            PG8_WAIT_L(8); PG8_BAR; PG8_WAIT_L(0); PG8_MMA(0, 0, At, B0); PG8_BAR; PG8_SCHED;
            PG8_LDB(B1, 1, 1); PG8_STAGE(PG8_SB(1, 0), b3, voffB);
            PG8_BAR; PG8_WAIT_L(0); PG8_MMA(0, 1, At, B1); PG8_BAR;
            PG8_LDA(At, 1, 1); PG8_STAGE(PG8_SA(1, 0), a3, voffA);
            PG8_BAR; PG8_WAIT_L(0); PG8_MMA(1, 0, At, B0); PG8_BAR; PG8_SCHED;
            PG8_STAGE(PG8_SB(1, 1), b3 + hstep, voffB);
            PG8_WAIT_V(6); PG8_BAR; PG8_MMA(1, 1, At, B1); PG8_BAR;
            }
        }
        if constexpr (ALIGN_EPI) { if (wr == 0) PG8_BAR; }
        if constexpr (!Epi::AFTER_DRAIN) { E(acc, cur, wr, wc, fr, fq); S.done(cur); }
        if (!has_next) break;
#pragma unroll
        for (int a = 0; a < 2; ++a)
#pragma unroll
            for (int b = 0; b < 2; ++b)
#pragma unroll
                for (int m = 0; m < 4; ++m)
#pragma unroll
                    for (int n = 0; n < 2; ++n) acc[a][b][m][n] = (f32x4){0.f, 0.f, 0.f, 0.f};
        cur = nxt; cA = nA; cB = nB; ++ui;
        if constexpr (ALIGN_EPI) { if (wr == 1) PG8_BAR; }
    }
    PG8_WAIT_V(0);
    if constexpr (!ALIGN_EPI) { if (wr == 0) PG8_BAR; }
    PG8_BAR;
    if constexpr (Epi::AFTER_DRAIN) { E.fused(acc, cur, wr, wc, fr, fq, lds, wid, lane); S.done(cur); }
#undef PG8_SA
#undef PG8_SB
#undef PG8_STAGE
#undef PG8_LDA
#undef PG8_LDB
#undef PG8_MMA
#undef PG8_WAIT_V
#undef PG8_WAIT_L
#undef PG8_BAR
#undef PG8_SCHED
}
}
typedef GAS unsigned gu32;
typedef GAS unsigned long long gu64;
#define RLX_AGENT __ATOMIC_RELAXED, __HIP_MEMORY_SCOPE_AGENT
#define LDS_WAIT() asm volatile("s_waitcnt lgkmcnt(0)" ::: "memory")
#define VM_WAIT() asm volatile("s_waitcnt vmcnt(0)" ::: "memory")
__device__ __forceinline__ unsigned long long rt() { return __builtin_amdgcn_s_memrealtime(); }
#define XB_TMO      128
#define XB_XCNT(j)  (256  + 64 * (j))
#define XB_XSUB(j)  (1280 + 64 * (j))
#define XB_XGEN(j)  (2304 + 64 * (j))
#define XB_TOP      3328
#define XB_TOPGEN   3392
#define XCD_BAR_WORDS 3456
#define XB_SPIN_CAP (1u << 18)

__device__ __forceinline__ unsigned xb_ld(unsigned* p)              { return __hip_atomic_load(p, __ATOMIC_RELAXED, __HIP_MEMORY_SCOPE_AGENT); }
__device__ __forceinline__ unsigned xb_add(unsigned* p, unsigned v) { return __hip_atomic_fetch_add(p, v, __ATOMIC_RELAXED, __HIP_MEMORY_SCOPE_AGENT); }
__device__ __forceinline__ unsigned xb_xcc_id() { return (unsigned)__builtin_amdgcn_s_getreg((3 << 11) | 20) & 0xFu; }
#define XB_SPIN(cond, bar) do { unsigned _sp = 0; while (cond) { __builtin_amdgcn_s_sleep(1); \
    if ((++_sp & 255u) == 0u) { if (xb_ld(&(bar)[XB_TMO])) break; if (_sp > XB_SPIN_CAP) { atomicAdd(&(bar)[XB_TMO], 1u); break; } } } } while (0)

struct XcdBarrier {
    unsigned* bar; unsigned x;
    volatile LAS unsigned* st;
};

__device__ __forceinline__ XcdBarrier xcd_barrier_post(unsigned* bar, volatile LAS unsigned* st) {
    XcdBarrier b; b.bar = bar; b.x = xb_xcc_id(); b.st = st;
    if (threadIdx.x == 0) (void)xb_add(&bar[XB_XCNT(b.x)], 1u);
    return b;
}
__device__ __forceinline__ void xcd_barrier_complete(unsigned* bar, unsigned x, unsigned& nloc, unsigned& nx) {
    const unsigned G = gridDim.x * gridDim.y * gridDim.z;
    unsigned sum, cnt, mine, sp = 0u;
    for (;;) {
        sum = 0u; cnt = 0u; mine = 0u;
#pragma unroll
        for (unsigned j = 0; j < 16; ++j) { const unsigned c = xb_ld(&bar[XB_XCNT(j)]); sum += c; cnt += (c > 0u) ? 1u : 0u; mine = (j == x) ? c : mine; }
        if (sum == G) break;
        __builtin_amdgcn_s_sleep(1);
        if ((++sp & 255u) == 0u) { if (xb_ld(&bar[XB_TMO])) break; if (sp > XB_SPIN_CAP) { atomicAdd(&bar[XB_TMO], 1u); break; } }
    }
    nloc = mine > 0u ? mine : 1u; nx = cnt > 0u ? cnt : 1u;
}

__device__ __forceinline__ void xcd_barrier(const XcdBarrier& b) {
    asm volatile("s_waitcnt vmcnt(0)" ::: "memory");
    __syncthreads();
    if (threadIdx.x == 0) {
        unsigned* bar = b.bar;
        __builtin_amdgcn_s_waitcnt(0);
        unsigned nloc = b.st[0], nx = b.st[1];
        if (nloc == 0u) { xcd_barrier_complete(bar, b.x, nloc, nx); b.st[0] = nloc; b.st[1] = nx; }
        const unsigned old = xb_add(&bar[XB_XSUB(b.x)], 1u);
        const unsigned gen = old / nloc;
        if (old + 1u == (gen + 1u) * nloc) {
            __builtin_amdgcn_fence(__ATOMIC_RELEASE, "agent");
            asm volatile("s_waitcnt vmcnt(0)" ::: "memory");
            const unsigned og = xb_add(&bar[XB_TOP], 1u);
            const unsigned tg = og / nx;
            if (og + 1u == (tg + 1u) * nx) xb_add(&bar[XB_TOPGEN], 1u);
            else XB_SPIN(xb_ld(&bar[XB_TOPGEN]) == tg, bar);
            __builtin_amdgcn_fence(__ATOMIC_ACQUIRE, "agent");
            xb_add(&bar[XB_XGEN(b.x)], 1u);
            asm volatile("s_waitcnt vmcnt(0)" ::: "memory");
        } else {
            XB_SPIN(xb_ld(&bar[XB_XGEN(b.x)]) == gen, bar);
            __builtin_amdgcn_fence(__ATOMIC_ACQUIRE, "agent");
            asm volatile("s_waitcnt vmcnt(0)" ::: "memory");
        }
    }
    __syncthreads();
}
constexpr int NWAVES = 8;
constexpr int LDS_BYTES = 147456;
constexpr int RING_BYTES = 131072;
constexpr int MISC_OFF = RING_BYTES + 320;
constexpr int CW_BAR = 4096;

struct Args { const float* in[N_IN]; float* out; unsigned char* ws; int ph_lo, ph_hi; };
struct Frame {
    LAS unsigned char* lds;
    const float* const* in; float* out; unsigned char* ws;
    int tid, lane, wave, vcu, G;
};

__device__ __forceinline__ void p0_transpose_item(const float* W, int K, int N, bf16* WT, LAS float* scr, int item, int lane) {
    const int nblk = N / 32, kb = item / nblk, nb = item % nblk, k0 = 64 * kb, n0 = 32 * nb;
#pragma unroll 8
    for (int i = 0; i < 32; ++i) { const int kk = 2 * i + (lane >> 5); scr[kk * 33 + (lane & 31)] = W[(size_t)(k0 + kk) * N + n0 + (lane & 31)]; }
    LDS_WAIT(); asm volatile("" ::: "memory");
    const int c = lane & 7;
#pragma unroll
    for (int j = 0; j < 4; ++j) { const int n = (lane >> 3) + 8 * j; const LAS float* s = scr + (8 * c) * 33 + n;
        v4u o; o.x = pk2(s[0 * 33], s[1 * 33]); o.y = pk2(s[2 * 33], s[3 * 33]); o.z = pk2(s[4 * 33], s[5 * 33]); o.w = pk2(s[6 * 33], s[7 * 33]);
        *(GAS v4u*)(WT + (size_t)(n0 + n) * K + k0 + 8 * c) = o; }
    LDS_WAIT(); asm volatile("" ::: "memory");
}
struct WMat { const float* src; bf16* dst; int K, N; };
__device__ __forceinline__ WMat wmat(const Frame& F, int mi) {
    WMat w; const int pr = mi >> 1, idx = mi & 1;
    if (mi < 10) {
        if (pr == 0)      { w.K = 1024; w.N = 1280; w.src = F.in[I_WINE]  + (size_t)idx * 1024 * 1280; w.dst = (bf16*)(F.ws + WS_WINE)  + (size_t)idx * 1280 * 1024; }
        else if (pr == 1) { w.K = 1024; w.N = 1024; w.src = F.in[I_WOUTE] + (size_t)idx * 1024 * 1024; w.dst = (bf16*)(F.ws + WS_WOUTE) + (size_t)idx * 1024 * 1024; }
        else if (pr == 2) { w.K = 512;  w.N = 512;  w.src = F.in[I_WGLU]  + (size_t)idx * 512 * 512;   w.dst = (bf16*)(F.ws + WS_WGLU)  + (size_t)idx * 512 * 512; }
        else if (pr == 3) { w.K = 1024; w.N = 4096; w.src = F.in[I_WINO]  + (size_t)idx * 1024 * 4096; w.dst = (bf16*)(F.ws + WS_WINO)  + (size_t)idx * 4096 * 1024; }
        else              { w.K = 1024; w.N = 1024; w.src = F.in[I_WOUTO] + (size_t)idx * 1024 * 1024; w.dst = (bf16*)(F.ws + WS_WOUTO) + (size_t)idx * 1024 * 1024; }
    } else if (mi < 14) { const int l = mi - 10; w.K = 1024; w.N = 4096; w.src = F.in[I_WUP] + (size_t)l * 1024 * 4096; w.dst = (bf16*)(F.ws + WS_WUP) + (size_t)l * 4096 * 1024; }
    else                { const int l = mi - 14; w.K = 4096; w.N = 1024; w.src = F.in[I_WDN] + (size_t)l * 4096 * 1024; w.dst = (bf16*)(F.ws + WS_WDN) + (size_t)l * 1024 * 4096; }
    return w;
}
__device__ __forceinline__ void rms_row_to_bf16(const f32x4 (&v)[4], const float* w, bf16* orow, int lane) {
    float s2 = 0.f;
#pragma unroll
    for (int j = 0; j < 4; ++j) s2 += (v[j].x * v[j].x + v[j].y * v[j].y) + (v[j].z * v[j].z + v[j].w * v[j].w);
    const float rstd = 1.0f / sqrtf(wave_sum(s2) * (1.f / DM) + RMS_EPS);
    GAS unsigned long long* o8 = (GAS unsigned long long*)orow + lane;
#pragma unroll
    for (int j = 0; j < 4; ++j) { const f32x4 ww = *((const GAS f32x4*)w + lane + 64 * j);
        o8[64 * j] = (unsigned long long)pk2(v[j].x * rstd * ww.x, v[j].y * rstd * ww.y) | ((unsigned long long)pk2(v[j].z * rstd * ww.z, v[j].w * rstd * ww.w) << 32); }
}
__device__ __forceinline__ void p0_prologue(const Frame& F) {
    LAS float* scr = (LAS float*)(F.lds + F.wave * 16384);
    const int gw = F.vcu * NWAVES + F.wave, NGW = F.G * NWAVES;
    for (int it = gw; it < 24064; it += NGW) {
        int r = it, mi = 0;
        for (;; ++mi) { const int pr = mi >> 1; const int cnt = (mi < 10) ? (pr == 0 ? 640 : pr == 1 ? 512 : pr == 2 ? 128 : pr == 3 ? 2048 : 512) : 2048; if (r < cnt) break; r -= cnt; }
        const WMat w = wmat(F, mi);
        p0_transpose_item(w.src, w.K, w.N, w.dst, scr, r, F.lane);
    }
    bf16* XN = (bf16*)(F.ws + WS_XN);
    for (int m = gw; m < MT; m += NGW) {
        const float* xrow = (m < TP) ? F.in[I_XP] + (size_t)m * DM : F.in[I_XS] + (size_t)(m - TP) * DM;
        const GAS f32x4* xr = (const GAS f32x4*)xrow + F.lane; GAS f32x4* xo = (GAS f32x4*)(F.out + (size_t)m * DM) + F.lane;
        f32x4 v[4];
#pragma unroll
        for (int j = 0; j < 4; ++j) { v[j] = xr[64 * j]; xo[64 * j] = v[j]; }
        rms_row_to_bf16(v, F.in[I_NMIXPRE], XN + (size_t)m * DM, F.lane);
    }
}
__device__ __forceinline__ void norm_res_phase(const Frame& F, const float* w_post, const float* w_next) {
    const int gw = F.vcu * NWAVES + F.wave, NGW = F.G * NWAVES;
    bf16* XN = (bf16*)(F.ws + WS_XN); const float* MIX = (const float*)(F.ws + WS_MIX);
    for (int m = gw; m < MT; m += NGW) {
        const GAS f32x4* mr = (const GAS f32x4*)(MIX + (size_t)m * DM) + F.lane; GAS f32x4* xo = (GAS f32x4*)(F.out + (size_t)m * DM) + F.lane;
        f32x4 h[4], v[4]; float s2 = 0.f;
#pragma unroll
        for (int j = 0; j < 4; ++j) { h[j] = mr[64 * j]; v[j] = xo[64 * j]; s2 += (h[j].x * h[j].x + h[j].y * h[j].y) + (h[j].z * h[j].z + h[j].w * h[j].w); }
        const float rstd = 1.0f / sqrtf(wave_sum(s2) * (1.f / DM) + RMS_EPS);
#pragma unroll
        for (int j = 0; j < 4; ++j) { const f32x4 ww = *((const GAS f32x4*)w_post + F.lane + 64 * j); v[j] = v[j] + h[j] * rstd * ww; xo[64 * j] = v[j]; }
        if (w_next) rms_row_to_bf16(v, w_next, XN + (size_t)m * DM, F.lane);
    }
}
__device__ __forceinline__ float gelu_tanh(float y) { const float z2 = 1.5957691216f * (y + 0.044715f * y * y * y); return y / (1.0f + __expf(-z2)); }
template <int MODE>
__device__ __forceinline__ void s5_unit(const Frame& F, int idx, int g, int cu, LAS unsigned char* himg) {
    const int lane = F.lane, j = lane & 31, half = lane >> 5;
    const bf16* PROJ = (const bf16*)(F.ws + WS_PROJ);
    float ar[2], ai[2]; bf16x8 Bf[4];
    const float dt = expf(F.in[I_LSTEP][idx * S5G + g]);
#pragma unroll
    for (int s = 0; s < 2; ++s) {
        const int p = j + 32 * s; const size_t gp = (size_t)(idx * S5G + g) * S5P + p;
        const float lr = F.in[I_LRE][gp], li = F.in[I_LIM][gp];
        const float mag = expf(lr * dt), ang = li * dt; float sn, cs; sincosf(ang, &sn, &cs);
        ar[s] = mag * cs; ai[s] = mag * sn;
        const float den = lr * lr + li * li, nr = ar[s] - 1.0f;
        const float cre = (nr * lr + ai[s] * li) / den, cim = (ai[s] * lr - nr * li) / den;
        const float* bre = F.in[I_BRE] + gp * S5C + 8 * half; const float* bim = F.in[I_BIM] + gp * S5C + 8 * half;
#pragma unroll
        for (int jj = 0; jj < 8; ++jj) { const float br = bre[jj], bi = bim[jj]; Bf[2 * s][jj] = (short)f2bf(cre * br - cim * bi); Bf[2 * s + 1][jj] = (short)f2bf(cre * bi + cim * br); }
    }
    bf16x8 Cf[4];
    if (MODE != 0) {
        const int c = lane & 15, q = lane >> 4; const float* cre = F.in[I_CRE] + ((size_t)(idx * S5G + g) * S5C + c) * S5P; const float* cim = F.in[I_CIM] + ((size_t)(idx * S5G + g) * S5C + c) * S5P;
#pragma unroll
        for (int ks = 0; ks < 4; ++ks)
#pragma unroll
            for (int jj = 0; jj < 8; ++jj) { const int k = 32 * ks + 8 * q + jj, p = (k >> 2) + 32 * ((k >> 1) & 1); Cf[ks][jj] = (short)f2bf((k & 1) ? -cim[p] : cre[p]); }
    }
    float hr[2] = {0.f, 0.f}, hi[2] = {0.f, 0.f};
    if (MODE == 1 && cu > 0) {
        float pr[2], pi[2];
#pragma unroll
        for (int s = 0; s < 2; ++s) { float xr = ar[s], xi = ai[s];
#pragma unroll
            for (int k = 0; k < 7; ++k) { const float nr = xr * xr - xi * xi, ni = 2.f * xr * xi; xr = nr; xi = ni; }
            pr[s] = xr; pi[s] = xi; }
        const float2* E = (const float2*)(F.ws + WS_S5E) + ((size_t)(half * S5G + g) * 64) * S5P + j;
        for (int c = 0; c < cu; ++c) {
#pragma unroll
            for (int s = 0; s < 2; ++s) { const float2 e = E[(size_t)c * S5P + 32 * s]; const float nr = pr[s] * hr[s] - pi[s] * hi[s] + e.x, ni = pr[s] * hi[s] + pi[s] * hr[s] + e.y; hr[s] = nr; hi[s] = ni; }
        }
    }
    const int arow_half = (j >> 2) & 1, arow_r = (j & 3) + 4 * (j >> 3);
    for (int tile = 0; tile < 8; ++tile) {
#define S5_ROW(hh, r) ((MODE == 2) ? (TP + (((cu * 8 + tile) * 8 + (hh) * 4 + ((r) >> 2)) * 4) + ((r) & 3)) : ((hh) * SEQ + cu * 128 + tile * 16 + (r)))
        const size_t arow = (size_t)S5_ROW(arow_half, arow_r);
        const bf16x8 af = *(const bf16x8*)(PROJ + arow * EVEN_IN + g * S5C + 8 * half);
        f32x16 acc[4];
#pragma unroll
        for (int tl = 0; tl < 4; ++tl) { f32x16 z;
#pragma unroll
            for (int e = 0; e < 16; ++e) z[e] = 0.f;
            acc[tl] = __builtin_amdgcn_mfma_f32_32x32x16_bf16(af, Bf[tl], z, 0, 0, 0); }
#pragma unroll
        for (int r = 0; r < 16; ++r) {
            if (MODE == 2 && (r & 3) == 0) {
                const int seq = (cu * 8 + tile) * 8 + half * 4 + (r >> 2); const size_t so = ((size_t)(idx * DECB + seq) * S5G + g) * S5P + j;
                hr[0] = F.in[I_SRE][so]; hr[1] = F.in[I_SRE][so + 32]; hi[0] = F.in[I_SIM][so]; hi[1] = F.in[I_SIM][so + 32];
            }
#pragma unroll
            for (int s = 0; s < 2; ++s) { const float nr = ar[s] * hr[s] - ai[s] * hi[s] + acc[2 * s][r], ni = ar[s] * hi[s] + ai[s] * hr[s] + acc[2 * s + 1][r]; hr[s] = nr; hi[s] = ni; acc[2 * s][r] = nr; acc[2 * s + 1][r] = ni; }
            if (MODE == 2 && (r & 3) == 3) {
                const int seq = (cu * 8 + tile) * 8 + half * 4 + (r >> 2); const size_t so = ((size_t)(idx * DECB + seq) * S5G + g) * S5P + j;
                F.out[O_RES + so] = hr[0]; F.out[O_RES + so + 32] = hr[1]; F.out[O_IMS + so] = hi[0]; F.out[O_IMS + so + 32] = hi[1];
            }
            if (MODE != 0) { v2u w; w.x = pk2(acc[0][r], acc[1][r]); w.y = pk2(acc[2][r], acc[3][r]); *(LAS v2u*)(himg + (half * 16 + r) * 272 + 8 * j) = w; }
        }
        if (MODE != 0) {
            LDS_WAIT();
            const int tok = lane & 15, q = lane >> 4;
#pragma unroll
            for (int bh = 0; bh < 2; ++bh) {
                f32x4 y = (f32x4){0.f, 0.f, 0.f, 0.f};
#pragma unroll
                for (int ks = 0; ks < 4; ++ks) { const bf16x8 hb = *(const LAS bf16x8*)(himg + (bh * 16 + tok) * 272 + ks * 64 + q * 16); y = __builtin_amdgcn_mfma_f32_16x16x32_bf16(Cf[ks], hb, y, 0, 0, 0); }
                const size_t row = (size_t)S5_ROW(bh, tok);
                const v2u uw = *(const v2u*)(PROJ + row * EVEN_IN + g * S5C + 4 * q);
                const f32x4 dsk = *(const f32x4*)(F.in[I_S5D] + idx * S5W + g * S5C + 4 * q);
                const float o0 = gelu_tanh(y[0] + dsk[0] * bflo(uw.x)), o1 = gelu_tanh(y[1] + dsk[1] * bfhi(uw.x)), o2 = gelu_tanh(y[2] + dsk[2] * bflo(uw.y)), o3 = gelu_tanh(y[3] + dsk[3] * bfhi(uw.y));
                v2u ow; ow.x = pk2(o0, o1); ow.y = pk2(o2, o3);
                *(v2u*)((bf16*)(F.ws + WS_G) + row * S5W + g * S5C + 4 * q) = ow;
            }
            LDS_WAIT();
        }
#undef S5_ROW
    }
    if (MODE == 0) { float2* E = (float2*)(F.ws + WS_S5E) + ((size_t)(half * S5G + g) * 64 + cu) * S5P + j; E[0] = make_float2(hr[0], hi[0]); E[32] = make_float2(hr[1], hi[1]); }
    if (MODE == 1 && cu == 63) { const size_t so = ((size_t)(idx * NB + half) * S5G + g) * S5P + j; F.out[O_REP + so] = hr[0]; F.out[O_REP + so + 32] = hr[1]; F.out[O_IMP + so] = hi[0]; F.out[O_IMP + so + 32] = hi[1]; }
}
__device__ __forceinline__ int t5_bucket(int n) {
    if (n < 16) return n;
    int b = 16 + (int)(logf((float)n / 16.0f) / 2.0794415416798357f * 16.0f);
    return b < 31 ? b : 31;
}
constexpr int SWA_KI = 0, SWA_VT = 36864, SWA_BIAS = 36864 + 33280;
__device__ __forceinline__ void swa_prompt_unit(const Frame& F, int idx, int unit) {
    const int b = unit >> 7, nb = (unit >> 1) & 63, kvh = unit & 1;
    LAS unsigned char* KI = F.lds + SWA_KI; LAS unsigned char* VT = F.lds + SWA_VT; LAS float* BIAS = (LAS float*)(F.lds + SWA_BIAS);
    const bf16* PROJ = (const bf16*)(F.ws + WS_PROJ);
    const int tid = F.tid, lane = F.lane, wave = F.wave;
#pragma unroll
    for (int it = 0; it < 4; ++it) {
        const int cidx = tid + 512 * it, key = cidx >> 3, ch = cidx & 7; const int kpos = (nb - 1) * 128 + key;
        v4u kw = (v4u){0u, 0u, 0u, 0u}, vw = (v4u){0u, 0u, 0u, 0u};
        if (kpos >= 0) { const bf16* src = PROJ + (size_t)(b * SEQ + kpos) * EVEN_IN + 1024 + kvh * 64 + ch * 8; kw = *(const v4u*)src; vw = *(const v4u*)(src + 128); }
        *(LAS v4u*)(KI + key * 144 + ch * 16) = kw;
        const unsigned vv[4] = {vw.x, vw.y, vw.z, vw.w};
#pragma unroll
        for (int e = 0; e < 4; ++e) { *(LAS bf16*)(VT + (ch * 8 + 2 * e) * 520 + key * 2) = (bf16)(vv[e] & 0xffffu); *(LAS bf16*)(VT + (ch * 8 + 2 * e + 1) * 520 + key * 2) = (bf16)(vv[e] >> 16); }
        if (nb == 63 && key >= 128) {
            const size_t oo = (((size_t)(idx * NB + b) * 128 + (key - 128)) * 2 + kvh) * 64 + ch * 8;
            const unsigned kk[4] = {kw.x, kw.y, kw.z, kw.w};
#pragma unroll
            for (int e = 0; e < 4; ++e) { F.out[O_KP + oo + 2 * e] = bflo(kk[e]); F.out[O_KP + oo + 2 * e + 1] = bfhi(kk[e]); F.out[O_VP + oo + 2 * e] = bflo(vv[e]); F.out[O_VP + oo + 2 * e + 1] = bfhi(vv[e]); }
        }
    }
    { const int hh = tid >> 7, dist = tid & 127; BIAS[tid] = F.in[I_T5][t5_bucket(dist) * SWH + kvh * 4 + hh]; }
    __syncthreads();
    const int q = lane & 31, h = lane >> 5, hh = wave >> 1, head = kvh * 4 + hh;
    const float sink = F.in[I_SINK][idx * SWH + head];
    for (int iu = 0; iu < 2; ++iu) {
        const int i = 2 * (wave & 1) + iu;
        const size_t qrow = (size_t)(b * SEQ + nb * 128 + 32 * i + q);
        bf16x8 Qf[4];
#pragma unroll
        for (int ks = 0; ks < 4; ++ks) Qf[ks] = *(const bf16x8*)(PROJ + qrow * EVEN_IN + 512 + head * 64 + 16 * ks + 8 * h);
        f32x16 S[5];
#pragma unroll
        for (int tl = 0; tl < 5; ++tl) {
#pragma unroll
            for (int e = 0; e < 16; ++e) S[tl][e] = 0.f;
#pragma unroll
            for (int ks = 0; ks < 4; ++ks) { const bf16x8 kf = *(const LAS bf16x8*)(KI + (32 * (i + tl) + q) * 144 + (16 * ks + 8 * h) * 2); S[tl] = __builtin_amdgcn_mfma_f32_32x32x16_bf16(kf, Qf[ks], S[tl], 0, 0, 0); }
        }
        const int t = 32 * i + q; float mx = -1e30f;
#pragma unroll
        for (int tl = 0; tl < 5; ++tl)
#pragma unroll
            for (int r = 0; r < 16; ++r) { const int m = 32 * (i + tl) + (r & 3) + 8 * (r >> 2) + 4 * h; const int dist = 128 + t - m;
                const bool valid = (dist >= 0) && (dist < 128) && (nb > 0 || m >= 128);
                const float sv = valid ? S[tl][r] * 0.125f + BIAS[hh * 128 + (dist & 127)] : -1e30f; S[tl][r] = sv; mx = fmaxf(mx, sv); }
        mx = fmaxf(mx, __shfl_xor(mx, 32)); const float M = fmaxf(mx, sink); float sum = 0.f;
#pragma unroll
        for (int tl = 0; tl < 5; ++tl)
#pragma unroll
            for (int r = 0; r < 16; ++r) { const float p = __expf(S[tl][r] - M); S[tl][r] = p; sum += p; }
        sum += __shfl_xor(sum, 32); const float inv = 1.0f / (sum + __expf(sink - M));
        f32x16 O[2];
#pragma unroll
        for (int e = 0; e < 16; ++e) { O[0][e] = 0.f; O[1][e] = 0.f; }
#pragma unroll
        for (int tl = 0; tl < 5; ++tl)
#pragma unroll
            for (int ss = 0; ss < 2; ++ss) {
                bf16x8 pf; { const unsigned w0 = pk2(S[tl][8 * ss + 0], S[tl][8 * ss + 1]), w1 = pk2(S[tl][8 * ss + 2], S[tl][8 * ss + 3]), w2 = pk2(S[tl][8 * ss + 4], S[tl][8 * ss + 5]), w3 = pk2(S[tl][8 * ss + 6], S[tl][8 * ss + 7]);
                    pf = __builtin_bit_cast(bf16x8, (v4u){w0, w1, w2, w3}); }
#pragma unroll
                for (int dt = 0; dt < 2; ++dt) {
                    const LAS unsigned char* vp = VT + (32 * dt + q) * 520 + (32 * (i + tl) + 16 * ss + 4 * h) * 2;
                    const v2u lo = *(const LAS v2u*)vp, hi2 = *(const LAS v2u*)(vp + 16);
                    const bf16x8 vf = __builtin_bit_cast(bf16x8, (v4u){lo.x, lo.y, hi2.x, hi2.y});
                    O[dt] = __builtin_amdgcn_mfma_f32_32x32x16_bf16(vf, pf, O[dt], 0, 0, 0);
                }
            }
        bf16* orow = (bf16*)(F.ws + WS_CAT) + qrow * DM + 512 + head * 64;
#pragma unroll
        for (int dt = 0; dt < 2; ++dt)
#pragma unroll
            for (int rg = 0; rg < 4; ++rg) { v2u w; w.x = pk2(O[dt][4 * rg] * inv, O[dt][4 * rg + 1] * inv); w.y = pk2(O[dt][4 * rg + 2] * inv, O[dt][4 * rg + 3] * inv); *(v2u*)(orow + 32 * dt + 8 * rg + 4 * h) = w; }
    }
    __syncthreads();
}
constexpr int SWS_K = 0, SWS_V = 34320, SWS_Q = 34320 + 33792, SWS_S = SWS_Q + 4096, SWS_BIAS = SWS_S + 8704;
__device__ __forceinline__ void swa_sample_unit(const Frame& F, int idx, int unit) {
    const int b = unit >> 1, kvh = unit & 1, tid = F.tid, lane = F.lane, wave = F.wave;
    LAS float* Ks = (LAS float*)(F.lds + SWS_K); LAS float* Vs = (LAS float*)(F.lds + SWS_V); LAS float* Qs = (LAS float*)(F.lds + SWS_Q); LAS float* Ss = (LAS float*)(F.lds + SWS_S); LAS float* BIAS = (LAS float*)(F.lds + SWS_BIAS);
    const bf16* PROJ = (const bf16*)(F.ws + WS_PROJ);
    for (int e = tid; e < 132 * 64; e += 512) {
        const int jk = e >> 6, d = e & 63; float kv, vv;
        if (jk < 128) { const size_t co = (((size_t)(idx * DECB + b) * 128 + jk) * 2 + kvh) * 64 + d; kv = F.in[I_CK][co]; vv = F.in[I_CV][co]; }
        else { const bf16* src = PROJ + (size_t)(TP + 4 * b + (jk - 128)) * EVEN_IN + 1024 + kvh * 64 + d; kv = bf2f(src[0]); vv = bf2f(src[128]); }
        Ks[jk * 65 + d] = kv; Vs[jk * 64 + d] = vv;
        if (jk >= 4) { const size_t oo = (((size_t)(idx * DECB + b) * 128 + (jk - 4)) * 2 + kvh) * 64 + d; F.out[O_KS + oo] = kv; F.out[O_VS + oo] = vv; }
    }
    for (int e = tid; e < 1024; e += 512) { const int rq = e >> 6, d = e & 63, i = rq >> 2, hh = rq & 3; Qs[e] = bf2f(PROJ[(size_t)(TP + 4 * b + i) * EVEN_IN + 512 + (kvh * 4 + hh) * 64 + d]); }
    { const int hh = tid >> 7, dist = tid & 127; BIAS[tid] = F.in[I_T5][t5_bucket(dist) * SWH + kvh * 4 + hh]; }
    __syncthreads();
    for (int pidx = tid; pidx < 16 * 132; pidx += 512) {
        const int rq = pidx / 132, jk = pidx - rq * 132, i = rq >> 2, hh = rq & 3; float dot = 0.f;
#pragma unroll 8
        for (int d = 0; d < 64; ++d) dot += Qs[rq * 64 + d] * Ks[jk * 65 + d];
        const int dist = 128 + i - jk; const bool valid = dist >= 0 && dist < 128;
        Ss[rq * 136 + jk] = valid ? dot * 0.125f + BIAS[hh * 128 + (dist & 127)] : -1e30f;
    }
    __syncthreads();
#pragma unroll
    for (int rr = 0; rr < 2; ++rr) {
        const int rq = 2 * wave + rr, hh = rq & 3; const float sink = F.in[I_SINK][idx * SWH + kvh * 4 + hh];
        const float s0 = Ss[rq * 136 + lane], s1 = Ss[rq * 136 + 64 + lane], s2 = (lane < 4) ? Ss[rq * 136 + 128 + lane] : -1e30f;
        float mx = fmaxf(fmaxf(s0, s1), s2);
#pragma unroll
        for (int o = 1; o < 64; o <<= 1) mx = fmaxf(mx, __shfl_xor(mx, o));
        const float M = fmaxf(mx, sink); const float p0 = __expf(s0 - M), p1 = __expf(s1 - M), p2 = __expf(s2 - M);
        const float inv = 1.0f / (wave_sum(p0 + p1 + p2) + __expf(sink - M));
        Ss[rq * 136 + lane] = p0 * inv; Ss[rq * 136 + 64 + lane] = p1 * inv; if (lane < 4) Ss[rq * 136 + 128 + lane] = p2 * inv;
    }
    __syncthreads();
    for (int e = tid; e < 1024; e += 512) {
        const int rq = e >> 6, d = e & 63, i = rq >> 2, hh = rq & 3; float o = 0.f;
        for (int jk = 0; jk < 132; ++jk) o += Ss[rq * 136 + jk] * Vs[jk * 64 + d];
        ((bf16*)(F.ws + WS_CAT))[(size_t)(TP + 4 * b + i) * DM + 512 + (kvh * 4 + hh) * 64 + d] = (bf16)f2bf(o);
    }
    __syncthreads();
}
__device__ __forceinline__ float hgrn_lb(const Frame& F, int idx, int c) {
    if (idx == 0) return 0.f;
    const float p0 = F.in[I_LB][c], p1 = F.in[I_LB][1024 + c], m = fmaxf(p0, p1), e0 = expf(p0 - m), e1 = expf(p1 - m), s = e0 + e1, s0 = e0 / s, s1 = e1 / s;
    return (s0 + s1) - s0;
}
__device__ __forceinline__ void hgrn_gate(float z, float lb, float& logf_, float& kf) {
    z = fminf(fmaxf(z, -80.f), 80.f);
    const float ez = __expf(-z), sig = 1.0f / (1.0f + ez);
    logf_ = __logf(fmaxf(lb, 1e-30f) + (1.0f - lb) * sig);
    kf = (1.0f - lb) * (ez * sig);
}
constexpr int HG_QI = 0, HG_KI = 17408, HG_KT = 34816, HG_VT = 53248, HG_SI = 71680, HG_RED = 106496, HG_BM = 108544, HG_BL = 109056, HG_NRM = 109568;
template <bool FULL>
__device__ __forceinline__ void hgrn_prompt_unit(const Frame& F, int idx, int unit) {
    const int bh = unit / NSC, sc = unit % NSC, b = bh >> 3, h = bh & 7;
    const int tid = F.tid, lane = F.lane, wave = F.wave, d = tid & 127, sq = tid >> 7, l31 = lane & 31, hl = lane >> 5;
    LAS unsigned char* L = F.lds;
    LAS float* RED = (LAS float*)(L + HG_RED); LAS float* BM = (LAS float*)(L + HG_BM); LAS float* BL = (LAS float*)(L + HG_BL); LAS float* NRM = (LAS float*)(L + HG_NRM);
    const bf16* PROJ = (const bf16*)(F.ws + WS_PROJ);
    const float lb = hgrn_lb(F, idx, h * 128 + d);
    const int vts = wave >> 1, dts0 = 2 * (wave & 1);
    const int tt = wave & 1, vt = wave >> 1;
    f32x16 Sacc[2];
    {
        const float* S0 = (const float*)(F.ws + WS_HS) + (size_t)unit * 16384;
#pragma unroll
        for (int k = 0; k < 2; ++k)
#pragma unroll
            for (int r = 0; r < 16; ++r) { const int v = 32 * vts + (r & 3) + 8 * (r >> 2) + 4 * hl, dd = 32 * (dts0 + k) + l31; Sacc[k][r] = (FULL && sc > 0) ? S0[v * 128 + dd] : 0.f; }
    }
    float sumbl = 0.f;
    for (int ch = 0; ch < SCT / HCH; ++ch) {
        const size_t row0 = (size_t)b * SEQ + (size_t)sc * SCT + ch * HCH;
        float cum[16], kf[16], qv[16]; float run = 0.f;
#pragma unroll
        for (int e = 0; e < 16; ++e) { const bf16* pr = PROJ + (row0 + sq * 16 + e) * ODD_IN + h * 128 + d;
            float lf; hgrn_gate(bf2f(pr[1024]), lb, lf, kf[e]); run += lf; cum[e] = run;
            if (FULL) { const float qq = bf2f(pr[0]); qv[e] = qq / (1.0f + __expf(-qq)); } }
        RED[sq * 128 + d] = run;
        __syncthreads();
        const float r0 = RED[d], r1 = RED[128 + d], r2 = RED[256 + d], r3 = RED[384 + d];
        const float off = (sq > 0 ? r0 : 0.f) + (sq > 1 ? r1 : 0.f) + (sq > 2 ? r2 : 0.f), bmid = r0 + r1, blast = (r0 + r1) + (r2 + r3);
        if (sq == 0) { BM[d] = bmid; BL[d] = blast; sumbl += blast; }
        {
            unsigned kw[8];
#pragma unroll
            for (int e = 0; e < 16; e += 2) {
                const float bt0 = off + cum[e], bt1 = off + cum[e + 1];
                const float k0 = kf[e] * __expf(bmid - bt0), k1 = kf[e + 1] * __expf(bmid - bt1);
                kw[e >> 1] = pk2(k0, k1);
                if (FULL) {
                    *(LAS bf16*)(L + HG_KI + (sq * 16 + e) * 272 + d * 2) = (bf16)(kw[e >> 1] & 0xffffu); *(LAS bf16*)(L + HG_KI + (sq * 16 + e + 1) * 272 + d * 2) = (bf16)(kw[e >> 1] >> 16);
                    *(LAS bf16*)(L + HG_QI + (sq * 16 + e) * 272 + d * 2) = (bf16)f2bf(qv[e] * __expf(bt0 - bmid)); *(LAS bf16*)(L + HG_QI + (sq * 16 + e + 1) * 272 + d * 2) = (bf16)f2bf(qv[e + 1] * __expf(bt1 - bmid));
                }
            }
            *(LAS v4u*)(L + HG_KT + d * 144 + sq * 32) = (v4u){kw[0], kw[1], kw[2], kw[3]}; *(LAS v4u*)(L + HG_KT + d * 144 + sq * 32 + 16) = (v4u){kw[4], kw[5], kw[6], kw[7]};
            unsigned vw[8];
#pragma unroll
            for (int e = 0; e < 16; e += 2) { const bf16* pv = PROJ + (row0 + sq * 16 + e) * ODD_IN + 2048 + h * 128 + d; vw[e >> 1] = (unsigned)pv[0] | ((unsigned)pv[ODD_IN] << 16); }
            *(LAS v4u*)(L + HG_VT + d * 144 + sq * 32) = (v4u){vw[0], vw[1], vw[2], vw[3]}; *(LAS v4u*)(L + HG_VT + d * 144 + sq * 32 + 16) = (v4u){vw[4], vw[5], vw[6], vw[7]};
        }
        __syncthreads();
        f32x16 O;
        if (FULL) {
#pragma unroll
            for (int k = 0; k < 2; ++k) { const int dd = 32 * (dts0 + k) + l31; const float em = __expf(BM[dd]);
#pragma unroll
                for (int r = 0; r < 16; ++r) { const int v = 32 * vts + (r & 3) + 8 * (r >> 2) + 4 * hl; *(LAS bf16*)(L + HG_SI + v * 272 + dd * 2) = (bf16)f2bf(Sacc[k][r] * em); } }
            __syncthreads();
            f32x16 X[2];
#pragma unroll
            for (int st = 0; st < 2; ++st) {
#pragma unroll
                for (int e = 0; e < 16; ++e) X[st][e] = 0.f;
                if (st <= tt) {
#pragma unroll
                    for (int ks = 0; ks < 8; ++ks) { const bf16x8 a = *(const LAS bf16x8*)(L + HG_KI + (32 * st + l31) * 272 + (16 * ks + 8 * hl) * 2), bq = *(const LAS bf16x8*)(L + HG_QI + (32 * tt + l31) * 272 + (16 * ks + 8 * hl) * 2);
                        X[st] = __builtin_amdgcn_mfma_f32_32x32x16_bf16(a, bq, X[st], 0, 0, 0); }
#pragma unroll
                    for (int r = 0; r < 16; ++r) { const int s = 32 * st + (r & 3) + 8 * (r >> 2) + 4 * hl, t = 32 * tt + l31; if (s > t) X[st][r] = 0.f; }
                }
            }
#pragma unroll
            for (int e = 0; e < 16; ++e) O[e] = 0.f;
#pragma unroll
            for (int st = 0; st < 2; ++st)
                if (st <= tt) {
#pragma unroll
                    for (int ss = 0; ss < 2; ++ss) {
                        const bf16x8 pf = __builtin_bit_cast(bf16x8, (v4u){pk2(X[st][8 * ss], X[st][8 * ss + 1]), pk2(X[st][8 * ss + 2], X[st][8 * ss + 3]), pk2(X[st][8 * ss + 4], X[st][8 * ss + 5]), pk2(X[st][8 * ss + 6], X[st][8 * ss + 7])});
                        const LAS unsigned char* vp = L + HG_VT + (32 * vt + l31) * 144 + (32 * st + 16 * ss + 4 * hl) * 2;
                        const v2u lo = *(const LAS v2u*)vp, hi2 = *(const LAS v2u*)(vp + 16);
                        O = __builtin_amdgcn_mfma_f32_32x32x16_bf16(__builtin_bit_cast(bf16x8, (v4u){lo.x, lo.y, hi2.x, hi2.y}), pf, O, 0, 0, 0);
                    }
                }
#pragma unroll
            for (int ks = 0; ks < 8; ++ks) { const bf16x8 a = *(const LAS bf16x8*)(L + HG_SI + (32 * vt + l31) * 272 + (16 * ks + 8 * hl) * 2), bq = *(const LAS bf16x8*)(L + HG_QI + (32 * tt + l31) * 272 + (16 * ks + 8 * hl) * 2);
                O = __builtin_amdgcn_mfma_f32_32x32x16_bf16(a, bq, O, 0, 0, 0); }
        }
#pragma unroll
        for (int k = 0; k < 2; ++k) {
            f32x16 Dl;
#pragma unroll
            for (int e = 0; e < 16; ++e) Dl[e] = 0.f;
            const int dd = 32 * (dts0 + k) + l31;
#pragma unroll
            for (int ks = 0; ks < 4; ++ks) { const bf16x8 a = *(const LAS bf16x8*)(L + HG_VT + (32 * vts + l31) * 144 + (16 * ks + 8 * hl) * 2), bk = *(const LAS bf16x8*)(L + HG_KT + dd * 144 + (16 * ks + 8 * hl) * 2);
                Dl = __builtin_amdgcn_mfma_f32_32x32x16_bf16(a, bk, Dl, 0, 0, 0); }
            const float el = __expf(BL[dd]), ed = __expf(BL[dd] - BM[dd]);
#pragma unroll
            for (int r = 0; r < 16; ++r) Sacc[k][r] = Sacc[k][r] * el + Dl[r] * ed;
        }
        if (FULL) {
            float ssq = 0.f;
#pragma unroll
            for (int r = 0; r < 16; ++r) ssq += O[r] * O[r];
            ssq += __shfl_xor(ssq, 32);
            if (hl == 0) NRM[vt * 64 + 32 * tt + l31] = ssq;
            __syncthreads();
            const int t = 32 * tt + l31; const float tot = (NRM[t] + NRM[64 + t]) + (NRM[128 + t] + NRM[192 + t]);
            const float rstd = 1.0f / sqrtf(tot * (1.0f / HDV) + RMS_EPS);
            const size_t row = row0 + t;
#pragma unroll
            for (int rg = 0; rg < 4; ++rg) { const int v0 = 32 * vt + 8 * rg + 4 * hl;
                const v2u gw = *(const v2u*)(PROJ + row * ODD_IN + 3072 + h * 128 + v0); const f32x4 gn = *(const f32x4*)(F.in[I_GN] + idx * HDV + v0);
                const float g0 = bflo(gw.x), g1 = bfhi(gw.x), g2 = bflo(gw.y), g3 = bfhi(gw.y);
                const float o0 = O[4 * rg] * rstd * gn[0] * (g0 / (1.0f + __expf(-g0))), o1 = O[4 * rg + 1] * rstd * gn[1] * (g1 / (1.0f + __expf(-g1))), o2 = O[4 * rg + 2] * rstd * gn[2] * (g2 / (1.0f + __expf(-g2))), o3 = O[4 * rg + 3] * rstd * gn[3] * (g3 / (1.0f + __expf(-g3)));
                v2u ow; ow.x = pk2(o0, o1); ow.y = pk2(o2, o3); *(v2u*)((bf16*)(F.ws + WS_CAT) + row * DM + h * 128 + v0) = ow; }
        } else {
            __syncthreads();
        }
    }
    if (!FULL) {
        float* U = (float*)(F.ws + WS_HU) + (size_t)unit * 16384;
#pragma unroll
        for (int k = 0; k < 2; ++k)
#pragma unroll
            for (int r = 0; r < 16; ++r) { const int v = 32 * vts + (r & 3) + 8 * (r >> 2) + 4 * hl, dd = 32 * (dts0 + k) + l31; U[v * 128 + dd] = Sacc[k][r]; }
        if (sq == 0) ((float*)(F.ws + WS_HD))[(size_t)unit * 128 + d] = sumbl;
    }
    __syncthreads();
}
__device__ __forceinline__ void hgrn_carry_phase(const Frame& F, int idx) {
    const float* U = (const float*)(F.ws + WS_HU); float* HSs = (float*)(F.ws + WS_HS); const float* HD = (const float*)(F.ws + WS_HD);
    for (int e = F.vcu * 512 + F.tid; e < 16 * 16384; e += F.G * 512) {
        const int bh = e >> 14, vd = e & 16383, v = vd >> 7, dd = vd & 127; float S = 0.f;
        for (int sc = 0; sc < NSC; ++sc) { const size_t u = (size_t)(bh * NSC + sc); HSs[u * 16384 + vd] = S; S = __expf(HD[u * 128 + dd]) * S + U[u * 16384 + vd]; }
        F.out[O_HP + ((size_t)(idx * 16 + bh) * 128 + dd) * 128 + v] = S;
    }
}
constexpr int HS_QH = 0, HS_KH = 2048, HS_EL = 4096, HS_V = 4608, HS_SC = 6656, HS_NR = 6784, HS_OP = 8192;
__device__ __forceinline__ void hgrn_sample_unit(const Frame& F, int idx, int unit) {
    const int b = unit >> 3, h = unit & 7, tid = F.tid, lane = F.lane, wave = F.wave;
    LAS float* QH = (LAS float*)(F.lds + HS_QH); LAS float* KH = (LAS float*)(F.lds + HS_KH); LAS float* EL = (LAS float*)(F.lds + HS_EL); LAS float* Vs = (LAS float*)(F.lds + HS_V);
    LAS float* SC = (LAS float*)(F.lds + HS_SC); LAS float* NR = (LAS float*)(F.lds + HS_NR); LAS float* OP = (LAS float*)(F.lds + HS_OP);
    const bf16* PROJ = (const bf16*)(F.ws + WS_PROJ); const size_t row0 = (size_t)TP + 4 * b;
    if (tid < 128) {
        const int d = tid; const float lb = hgrn_lb(F, idx, h * 128 + d);
        float bt[4], kf[4], qf[4]; float run = 0.f;
#pragma unroll
        for (int t = 0; t < 4; ++t) { const bf16* pr = PROJ + (row0 + t) * ODD_IN + h * 128 + d; float lf; hgrn_gate(bf2f(pr[1024]), lb, lf, kf[t]); run += lf; bt[t] = run; const float qq = bf2f(pr[0]); qf[t] = qq / (1.0f + __expf(-qq)); Vs[t * 128 + d] = bf2f(pr[2048]); }
#pragma unroll
        for (int t = 0; t < 4; ++t) { QH[t * 128 + d] = qf[t] * __expf(bt[t]); KH[t * 128 + d] = kf[t] * __expf(bt[3] - bt[t]); }
        EL[d] = __expf(bt[3]);
#pragma unroll
        for (int t = 0; t < 4; ++t)
#pragma unroll
            for (int s = 0; s < 4; ++s) { const float pr = (s <= t) ? qf[t] * kf[s] * __expf(bt[t] - bt[s]) : 0.f; const float ws = wave_sum(pr); if (lane == 0) SC[wave * 16 + t * 4 + s] = ws; }
    }
    __syncthreads();
    {
        const int vq = tid & 31, dg = tid >> 5; const size_t so = ((size_t)(idx * DECB + b) * HH + h) * 16384;
        const float* S0 = F.in[I_SH] + so; float* SN = F.out + O_HS + so;
        f32x4 op[4];
#pragma unroll
        for (int t = 0; t < 4; ++t) op[t] = (f32x4){0.f, 0.f, 0.f, 0.f};
        f32x4 v4[4];
#pragma unroll
        for (int s = 0; s < 4; ++s) v4[s] = *(const LAS f32x4*)(Vs + s * 128 + 4 * vq);
#pragma unroll
        for (int i = 0; i < 8; ++i) {
            const int dd = dg * 8 + i; const f32x4 s4 = *(const f32x4*)(S0 + dd * 128 + 4 * vq);
            f32x4 sn = s4 * EL[dd];
#pragma unroll
            for (int s = 0; s < 4; ++s) sn += v4[s] * KH[s * 128 + dd];
            *(f32x4*)(SN + dd * 128 + 4 * vq) = sn;
#pragma unroll
            for (int t = 0; t < 4; ++t) op[t] += s4 * QH[t * 128 + dd];
        }
#pragma unroll
        for (int t = 0; t < 4; ++t) *(LAS f32x4*)(OP + (dg * 4 + t) * 128 + 4 * vq) = op[t];
    }
    __syncthreads();
    {
        const int t = tid >> 7, v = tid & 127; float o = 0.f;
#pragma unroll
        for (int dg = 0; dg < 16; ++dg) o += OP[(dg * 4 + t) * 128 + v];
#pragma unroll
        for (int s = 0; s < 4; ++s) if (s <= t) o += (SC[t * 4 + s] + SC[16 + t * 4 + s]) * Vs[s * 128 + v];
        const float ss = wave_sum(o * o); if (lane == 0) NR[wave] = ss;
        __syncthreads();
        const float tot = NR[2 * t] + NR[2 * t + 1]; const float rstd = 1.0f / sqrtf(tot * (1.0f / HDV) + RMS_EPS);
        const float gz = bf2f(PROJ[(row0 + t) * ODD_IN + 3072 + h * 128 + v]);
        ((bf16*)(F.ws + WS_CAT))[(row0 + t) * DM + h * 128 + v] = (bf16)f2bf(o * rstd * F.in[I_GN][idx * HDV + v] * (gz / (1.0f + __expf(-gz))));
    }
    __syncthreads();
}
constexpr int N_PHASES = 37;
#ifndef MK_ONE_LAUNCH
#define MK_ONE_LAUNCH 0
#endif

template <class Epi> __device__ __forceinline__ void run_gemm(const Frame& F, const bf16* A, const bf16* Bt, int N, int K, const Epi& E) {
    pg8::Gemm g{A, Bt, MT, N, K}; pg8::StaticOrder S; S.init(MT, N, F.G, (int)blockIdx.x);
    pg8::gemm_phase<Epi, pg8::StaticOrder, true, true>(F.lds, g, S, E);
}


#define PH_BAR() do { if (cur + 1 < hi) xcd_barrier(bar); } while (0)
#define PHASE(body) do { if (lo <= cur && cur < hi) { { int t_ = threadIdx.x; asm volatile("" : "+v"(t_)); F.tid = t_; F.lane = t_ & 63; F.wave = __builtin_amdgcn_readfirstlane(t_ >> 6); } body; PH_BAR(); } ++cur; } while (0)

__global__ void __launch_bounds__(NWAVES * 64, 2) mega_fwd(Args args) {
    extern __shared__ __attribute__((aligned(16))) unsigned char lds[];
    Frame F;
    F.lds = (LAS unsigned char*)lds; F.in = args.in; F.out = args.out; F.ws = args.ws;
    F.tid = threadIdx.x; F.lane = F.tid & 63; F.wave = __builtin_amdgcn_readfirstlane(F.tid >> 6);
    F.G = gridDim.x; { const int bx = blockIdx.x; F.vcu = (F.G % 8 == 0) ? (bx % 8) * (F.G / 8) + bx / 8 : bx; }
    volatile LAS unsigned* MISC = (volatile LAS unsigned*)(F.lds + MISC_OFF);
    for (int u = F.tid; u < (LDS_BYTES - RING_BYTES) / 4; u += NWAVES * 64) ((LAS unsigned*)(F.lds + RING_BYTES))[u] = 0u;
    __syncthreads();
    const int lo = args.ph_lo, hi = args.ph_hi;
    XcdBarrier bar; bar.bar = (unsigned*)(args.ws + WS_CTL) + CW_BAR; bar.x = 0; bar.st = nullptr;
    if (hi - lo > 1) bar = xcd_barrier_post((unsigned*)(args.ws + WS_CTL) + CW_BAR, MISC + 8);
    bf16* const XN = (bf16*)(F.ws + WS_XN); bf16* const CAT = (bf16*)(F.ws + WS_CAT); bf16* const G = (bf16*)(F.ws + WS_G); bf16* const PROJ = (bf16*)(F.ws + WS_PROJ); float* const MIX = (float*)(F.ws + WS_MIX);
    int cur = 0;
    PHASE(p0_prologue(F));
#pragma unroll 1
    for (int idx = 0; idx < 2; ++idx) {
        { const int l = 2 * idx;
        PHASE(run_gemm(F, XN, (const bf16*)(F.ws + WS_WINE) + (size_t)idx * EVEN_IN * DM, EVEN_IN, DM, pg8::EpiBf16<0>{PROJ, EVEN_IN}));
        PHASE({ for (int u = F.vcu; u < 256; u += F.G) swa_prompt_unit(F, idx, u);
                for (int u = F.vcu; u < 256; u += F.G) swa_sample_unit(F, idx, u);
                for (int u = F.vcu * NWAVES + F.wave; u < 2048; u += F.G * NWAVES) s5_unit<0>(F, idx, u & 31, u >> 5, F.lds + F.wave * 8704); });
        PHASE({ for (int u = F.vcu * NWAVES + F.wave; u < 2048; u += F.G * NWAVES) s5_unit<1>(F, idx, u & 31, u >> 5, F.lds + F.wave * 8704);
                for (int u = F.vcu * NWAVES + F.wave; u < 64; u += F.G * NWAVES) s5_unit<2>(F, idx, u & 31, u >> 5, F.lds + F.wave * 8704); });
        PHASE(run_gemm(F, G, (const bf16*)(F.ws + WS_WGLU) + (size_t)idx * S5W * S5W, S5W, S5W, pg8::EpiGlu{G, S5W, CAT, DM}));
        PHASE(run_gemm(F, CAT, (const bf16*)(F.ws + WS_WOUTE) + (size_t)idx * DM * DM, DM, DM, pg8::EpiF32{MIX, DM}));
        PHASE(norm_res_phase(F, F.in[I_NMIXPOST] + l * DM, F.in[I_NMLPPRE] + l * DM));
        PHASE(run_gemm(F, XN, (const bf16*)(F.ws + WS_WUP) + (size_t)l * DFF * DM, DFF, DM, pg8::EpiBf16<2>{PROJ, DFF}));
        PHASE(run_gemm(F, PROJ, (const bf16*)(F.ws + WS_WDN) + (size_t)l * DM * DFF, DM, DFF, pg8::EpiF32{MIX, DM}));
        PHASE(norm_res_phase(F, F.in[I_NMLPPOST] + l * DM, F.in[I_NMIXPRE] + (l + 1) * DM)); }
        { const int l = 2 * idx + 1;
        PHASE(run_gemm(F, XN, (const bf16*)(F.ws + WS_WINO) + (size_t)idx * ODD_IN * DM, ODD_IN, DM, pg8::EpiBf16<0>{PROJ, ODD_IN}));
        PHASE({ for (int u = F.vcu; u < 16 * NSC; u += F.G) hgrn_prompt_unit<false>(F, idx, u);
                for (int u = F.vcu; u < DECB * HH; u += F.G) hgrn_sample_unit(F, idx, u); });
        PHASE(hgrn_carry_phase(F, idx));
        PHASE({ for (int u = F.vcu; u < 16 * NSC; u += F.G) hgrn_prompt_unit<true>(F, idx, u); });
        PHASE(run_gemm(F, CAT, (const bf16*)(F.ws + WS_WOUTO) + (size_t)idx * DM * DM, DM, DM, pg8::EpiF32{MIX, DM}));
        PHASE(norm_res_phase(F, F.in[I_NMIXPOST] + l * DM, F.in[I_NMLPPRE] + l * DM));
        PHASE(run_gemm(F, XN, (const bf16*)(F.ws + WS_WUP) + (size_t)l * DFF * DM, DFF, DM, pg8::EpiBf16<2>{PROJ, DFF}));
        PHASE(run_gemm(F, PROJ, (const bf16*)(F.ws + WS_WDN) + (size_t)l * DM * DFF, DM, DFF, pg8::EpiF32{MIX, DM}));
        PHASE(norm_res_phase(F, F.in[I_NMLPPOST] + l * DM, (l < 3) ? F.in[I_NMIXPRE] + (l + 1) * DM : nullptr)); }
    }
}

extern "C" void kernel_launch(void* const* d_in, const int* in_sizes, int n_in, void* d_out, int out_size, void* d_ws, size_t ws_size, hipStream_t stream) {
    static int grid = 0;
    if (grid == 0) {
        if (n_in != N_IN || (size_t)out_size != O_END || ws_size < WS_END) { fprintf(stderr, "kernel_launch: unexpected problem (n_in %d, out %d, ws %zu); nothing launched\n", n_in, out_size, ws_size); grid = -1; return; }
        int dev = 0, cus = 0, per_cu = 0;
        if (hipGetDevice(&dev) != hipSuccess || hipDeviceGetAttribute(&cus, hipDeviceAttributeMultiprocessorCount, dev) != hipSuccess) { grid = -1; return; }
        if (hipFuncSetAttribute((const void*)mega_fwd, hipFuncAttributeMaxDynamicSharedMemorySize, LDS_BYTES) != hipSuccess) { fprintf(stderr, "kernel_launch: hipFuncSetAttribute failed\n"); grid = -1; return; }
        if (hipOccupancyMaxActiveBlocksPerMultiprocessor(&per_cu, (const void*)mega_fwd, NWAVES * 64, LDS_BYTES) != hipSuccess || per_cu < 1) { fprintf(stderr, "kernel_launch: occupancy query says %d blocks per CU\n", per_cu); }
        (void)hipGetLastError();
        grid = cus;
    }
    if (grid < 0) return;
    if (hipMemsetAsync((char*)d_ws + WS_CTL, 0, CTL_ZERO_BYTES, stream) != hipSuccess) { fprintf(stderr, "kernel_launch: memset failed\n"); return; }
    Args a{};
    for (int i = 0; i < N_IN; ++i) a.in[i] = (const float*)d_in[i];
    a.out = (float*)d_out; a.ws = (unsigned char*)d_ws;
#if MK_ONE_LAUNCH
    a.ph_lo = 0; a.ph_hi = N_PHASES;
    hipLaunchKernelGGL(mega_fwd, dim3(grid), dim3(NWAVES * 64), LDS_BYTES, stream, a);
#else
    for (int ph = 0; ph < N_PHASES; ++ph) { a.ph_lo = ph; a.ph_hi = ph + 1; hipLaunchKernelGGL(mega_fwd, dim3(grid), dim3(NWAVES * 64), LDS_BYTES, stream, a); }
#endif
    const hipError_t le = hipPeekAtLastError();
    if (le != hipSuccess) fprintf(stderr, "kernel_launch: launch failed: %s\n", hipGetErrorName(le));
}
```

```cpp
#include <hip/hip_runtime.h>
#include <cstdio>
#include <cstdint>

constexpr int DM = 1024, SEQ = 8192, NB = 2, TP = NB * SEQ, DECB = 128, DECL = 4, TS = DECB * DECL, MT = TP + TS;
constexpr int EVEN_IN = 1280, ODD_IN = 4096, DFF = 4096;
constexpr int S5G = 32, S5C = 16, S5P = 64, S5W = 512;
constexpr int SWH = 8, SWKV = 2, SWG = 4, SWD = 64, WIN = 128;
constexpr int HH = 8, HDK = 128, HDV = 128, HCH = 64;
constexpr float RMS_EPS = 1e-6f;
constexpr size_t O_Y = 0, O_KP = (size_t)MT * DM, O_VP = O_KP + 65536, O_KS = O_VP + 65536, O_VS = O_KS + 4194304, O_REP = O_VS + 4194304, O_IMP = O_REP + 8192,
                 O_RES = O_IMP + 8192, O_IMS = O_RES + 524288, O_HP = O_IMS + 524288, O_HS = O_HP + 524288, O_END = O_HS + 33554432;
enum { I_XP = 0, I_XS, I_CK, I_CV, I_SRE, I_SIM, I_SH, I_T5, I_NMIXPRE, I_NMIXPOST, I_NMLPPRE, I_NMLPPOST, I_WINE, I_WOUTE, I_LRE, I_LIM, I_LSTEP, I_BRE, I_BIM, I_CRE, I_CIM, I_S5D, I_WGLU,
       I_SINK, I_WINO, I_WOUTO, I_LB, I_GN, I_WUP, I_WDN, N_IN };
constexpr size_t MiB = 1u << 20;
constexpr size_t WS_CTL = 0, CTL_ZERO_BYTES = 1 * MiB;
constexpr size_t WS_WINE = 2 * MiB, WS_WOUTE = 7 * MiB, WS_WGLU = 11 * MiB, WS_WINO = 12 * MiB, WS_WOUTO = 28 * MiB, WS_WUP = 32 * MiB, WS_WDN = 64 * MiB;
constexpr size_t WS_XN = 96 * MiB, WS_CAT = 129 * MiB, WS_G = 162 * MiB, WS_PROJ = 179 * MiB, WS_MIX = 311 * MiB, WS_S5E = 377 * MiB, WS_HU = 379 * MiB, WS_HS = 411 * MiB, WS_HD = 443 * MiB, WS_END = 444 * MiB;
constexpr int NSC = 32, SCT = SEQ / NSC;

#define GAS __attribute__((address_space(1)))
#define LAS __attribute__((address_space(3)))
typedef unsigned short bf16;
typedef unsigned v4u __attribute__((ext_vector_type(4)));
typedef unsigned v2u __attribute__((ext_vector_type(2)));
typedef float f32x4 __attribute__((ext_vector_type(4)));
typedef float f32x16 __attribute__((ext_vector_type(16)));
typedef short bf16x8 __attribute__((ext_vector_type(8)));
typedef short s16x4 __attribute__((ext_vector_type(4)));
__device__ __forceinline__ unsigned f2bf(float f) { unsigned u = __builtin_bit_cast(unsigned, f); return (u + 0x7fffu + ((u >> 16) & 1u)) >> 16; }
__device__ __forceinline__ unsigned pk2(float lo, float hi) { return f2bf(lo) | (f2bf(hi) << 16); }
__device__ __forceinline__ float bflo(unsigned w) { return __builtin_bit_cast(float, w << 16); }
__device__ __forceinline__ float bfhi(unsigned w) { return __builtin_bit_cast(float, w & 0xffff0000u); }
__device__ __forceinline__ float bf2f(bf16 h) { return __builtin_bit_cast(float, (unsigned)h << 16); }
__device__ __forceinline__ float wave_sum(float v) {
#pragma unroll
    for (int o = 1; o < 64; o <<= 1) v += __shfl_xor(v, o);
    return v;
}
__device__ __forceinline__ float sigmoidf_(float x) { return 1.0f / (1.0f + __expf(-x)); }
namespace pg8 {
#define PG8_LAS __attribute__((address_space(3)))
typedef unsigned short bf16_t;
typedef short bf16x8 __attribute__((ext_vector_type(8)));
typedef float f32x4 __attribute__((ext_vector_type(4)));
typedef unsigned u32x4 __attribute__((ext_vector_type(4)));
constexpr int BM = 256, BK = 64, HALF = 128, HTB = HALF * BK * 2  , STAGE_BYTES = 8 * HTB, NXCD = 8, WGM = 8;

__host__ __device__ __forceinline__ int lds_byte(int r, int c) { const int st = (r >> 4) * 2 + (c >> 5), rr = r & 15, cc = c & 31, ob = rr * 64 + cc * 2; return st * 1024 + (ob ^ (((ob >> 9) & 1) << 5)); }
__host__ __device__ __forceinline__ void stage_rc(int b, int& R, int& C) { const int st = b / 1024, sb = b % 1024, swz = sb ^ (((sb >> 9) & 1) << 5); R = (st >> 1) * 16 + swz / 64; C = (st & 1) * 32 + (swz % 64) / 2; }
__host__ __device__ __forceinline__ int perm32(int rho) { const int n = rho >> 4, i = rho & 15; return 8 * (i >> 2) + 4 * n + (i & 3); }

struct Unit { int pm, pn; };
struct Gemm { const bf16_t* A; const bf16_t* Bt; int M, N, K; };

struct StaticOrder {
    int nM, nN, nwg, G, c;
    __host__ __device__ void init(int M, int N, int G_, int c_) { nM = M / BM; nN = N / BM; nwg = nM * nN; G = G_; c = c_; }
    __host__ __device__ bool next(int i, Unit& u) const {
        const long L = (long)i * G + c; if (L >= nwg) return false;
        int wgid = (int)L; { const int q = nwg / NXCD, r = nwg % NXCD, xcd = wgid % NXCD, off = wgid / NXCD; wgid = (xcd < r ? xcd * (q + 1) : r * (q + 1) + (xcd - r) * q) + off; }
        const int nig = WGM * nN, gid = wgid / nig, fm = gid * WGM, gsz = (nM - fm) < WGM ? (nM - fm) : WGM;
        u.pm = fm + ((wgid % nig) % gsz); u.pn = (wgid % nig) / gsz; return true;
    }
    __device__ __forceinline__ void a_ready(const Unit&) const {}
    __device__ __forceinline__ void done(const Unit&) const {}
};

__device__ __forceinline__ unsigned cvt_pk_bf16(float lo, float hi) { unsigned r; asm volatile("v_cvt_pk_bf16_f32 %0, %1, %2" : "=v"(r) : "v"(lo), "v"(hi)); return r; }
struct EpiF32 {
    static constexpr bool PERM = false, AFTER_DRAIN = false;
    float* C; int ldc;
    __device__ __forceinline__ void operator()(const f32x4 (&acc)[2][2][4][2], const Unit& u, int wr, int wc, int fr, int fq) const {
        const int row0 = u.pm * BM + wr * 64 + fr, col0 = u.pn * BM + wc * 32 + 4 * fq;
#pragma unroll
        for (int ai = 0; ai < 2; ++ai)
#pragma unroll
            for (int m = 0; m < 4; ++m) { float* rowp = C + (size_t)(row0 + ai * HALF + m * 16) * ldc + col0;
#pragma unroll
                for (int bj = 0; bj < 2; ++bj)
#pragma unroll
                    for (int n = 0; n < 2; ++n) *(f32x4*)(rowp + bj * HALF + n * 16) = acc[ai][bj][m][n]; }
    }
};
template <int ACT  > struct EpiBf16 {
    static constexpr bool PERM = true, AFTER_DRAIN = false;
    bf16_t* O; int ldc;
    __device__ __forceinline__ void operator()(const f32x4 (&acc)[2][2][4][2], const Unit& u, int wr, int wc, int fr, int fq) const {
        const int row0 = u.pm * BM + wr * 64 + fr; const int col0 = u.pn * BM + wc * 32 + 8 * fq;
#pragma unroll
        for (int ai = 0; ai < 2; ++ai)
#pragma unroll
            for (int m = 0; m < 4; ++m) { bf16_t* rowp = O + (size_t)(row0 + ai * HALF + m * 16) * ldc + col0;
#pragma unroll
                for (int bj = 0; bj < 2; ++bj) { f32x4 v0 = acc[ai][bj][m][0], v1 = acc[ai][bj][m][1];
                    if (ACT == 2) {
#pragma unroll
                        for (int e = 0; e < 4; ++e) { const float a = v0[e] > 0.f ? v0[e] : 0.f, b = v1[e] > 0.f ? v1[e] : 0.f; v0[e] = a * a; v1[e] = b * b; } }
                    u32x4 w; w.x = cvt_pk_bf16(v0[0], v0[1]); w.y = cvt_pk_bf16(v0[2], v0[3]); w.z = cvt_pk_bf16(v1[0], v1[1]); w.w = cvt_pk_bf16(v1[2], v1[3]);
                    *(u32x4*)(rowp + bj * HALF) = w; } }
    }
};
struct EpiGlu {
    static constexpr bool PERM = true, AFTER_DRAIN = false;
    const bf16_t* Gm; int ldg; bf16_t* O; int ldc;
    __device__ __forceinline__ void operator()(const f32x4 (&acc)[2][2][4][2], const Unit& u, int wr, int wc, int fr, int fq) const {
        const int row0 = u.pm * BM + wr * 64 + fr; const int col0 = u.pn * BM + wc * 32 + 8 * fq;
#pragma unroll
        for (int ai = 0; ai < 2; ++ai)
#pragma unroll
            for (int m = 0; m < 4; ++m) { const size_t row = (size_t)(row0 + ai * HALF + m * 16);
#pragma unroll
                for (int bj = 0; bj < 2; ++bj) { const f32x4 v0 = acc[ai][bj][m][0], v1 = acc[ai][bj][m][1];
                    const u32x4 gw = *(const u32x4*)(Gm + row * ldg + col0 + bj * HALF);
                    float gv[8]; gv[0] = __builtin_bit_cast(float, gw.x << 16); gv[1] = __builtin_bit_cast(float, gw.x & 0xffff0000u); gv[2] = __builtin_bit_cast(float, gw.y << 16); gv[3] = __builtin_bit_cast(float, gw.y & 0xffff0000u);
                    gv[4] = __builtin_bit_cast(float, gw.z << 16); gv[5] = __builtin_bit_cast(float, gw.z & 0xffff0000u); gv[6] = __builtin_bit_cast(float, gw.w << 16); gv[7] = __builtin_bit_cast(float, gw.w & 0xffff0000u);
                    float o[8];
#pragma unroll
                    for (int e = 0; e < 4; ++e) { o[e] = gv[e] / (1.0f + __expf(-v0[e])); o[4 + e] = gv[4 + e] / (1.0f + __expf(-v1[e])); }
                    u32x4 w; w.x = cvt_pk_bf16(o[0], o[1]); w.y = cvt_pk_bf16(o[2], o[3]); w.z = cvt_pk_bf16(o[4], o[5]); w.w = cvt_pk_bf16(o[6], o[7]);
                    *(u32x4*)(O + row * ldc + col0 + bj * HALF) = w; } }
    }
};
template <class Epi, class Sched, bool ALIGN_EPI = false, bool SP2 = false>
__device__ __forceinline__ void gemm_phase(PG8_LAS unsigned char* lds, const Gemm g, const Sched& S, const Epi& E) {
    int tid_ = threadIdx.x; asm volatile("" : "+v"(tid_));
    const int tid = tid_, wid = __builtin_amdgcn_readfirstlane(tid >> 6), lane = tid & 63, wr = wid >> 2, wc = wid & 3, fr = lane & 15, fq = lane >> 4;
    const int K = g.K, nt = K / BK;
    unsigned voffA[2], voffB[2];
#pragma unroll
    for (int i = 0; i < 2; ++i) { int R, C; stage_rc(tid * 16 + i * 8192, R, C); const int Rb = Epi::PERM ? ((R & ~31) + perm32(R & 31)) : R;
        voffA[i] = (unsigned)(R * K + C) * 2u; voffB[i] = (unsigned)(Rb * K + C) * 2u; }
    const size_t kstep = (size_t)(BK * 2);
    const size_t hstep = (size_t)HALF * K * 2;
    const size_t tstep = 2 * hstep;
    const unsigned ldsw = (unsigned)wid * 1024u;
    const int aoff = lds_byte(wr * 64 + fr, fq * 8), boff = lds_byte(wc * 32 + fr, fq * 8);
#define PG8_SA(b, h) (((b) * 2 + (h)) * HTB)
#define PG8_SB(b, h) ((4 + (b) * 2 + (h)) * HTB)
#define PG8_STAGE(bufoff, gbase, voff) do { _Pragma("unroll") for (int _i = 0; _i < 2; ++_i) \
        __builtin_amdgcn_global_load_lds((const unsigned*)((const char*)(gbase) + (voff)[_i]), (PG8_LAS unsigned*)(lds + (bufoff) + ldsw + _i * 8192), 16, 0, 0); } while (0)
#define PG8_LDA(dst, b, h) do { _Pragma("unroll") for (int m = 0; m < 4; ++m) _Pragma("unroll") for (int k = 0; k < 2; ++k) dst[m][k] = *(const PG8_LAS bf16x8*)(lds + PG8_SA(b, h) + aoff + m * 2048 + k * 1024); } while (0)
#define PG8_LDB(dst, b, h) do { _Pragma("unroll") for (int n = 0; n < 2; ++n) _Pragma("unroll") for (int k = 0; k < 2; ++k) dst[n][k] = *(const PG8_LAS bf16x8*)(lds + PG8_SB(b, h) + boff + n * 2048 + k * 1024); } while (0)
#define PG8_MMA(ai, bj, At, Bt) do { __builtin_amdgcn_s_setprio(1); _Pragma("unroll") for (int m = 0; m < 4; ++m) _Pragma("unroll") for (int n = 0; n < 2; ++n) _Pragma("unroll") for (int k = 0; k < 2; ++k) \
        acc[ai][bj][m][n] = __builtin_amdgcn_mfma_f32_16x16x32_bf16(Bt[n][k], At[m][k], acc[ai][bj][m][n], 0, 0, 0); __builtin_amdgcn_s_setprio(0); } while (0)
#define PG8_WAIT_V(n) asm volatile("s_waitcnt vmcnt(" #n ")" ::: "memory")
#define PG8_WAIT_L(n) asm volatile("s_waitcnt lgkmcnt(" #n ")" ::: "memory")
#define PG8_BAR __builtin_amdgcn_s_barrier()
#define PG8_SCHED __builtin_amdgcn_sched_barrier(0)
    Unit cur, nxt; int ui = 0;
    if (!S.next(0, cur)) return;
    f32x4 acc[2][2][4][2];
#pragma unroll
    for (int a = 0; a < 2; ++a)
#pragma unroll
        for (int b = 0; b < 2; ++b)
#pragma unroll
            for (int m = 0; m < 4; ++m)
#pragma unroll
                for (int n = 0; n < 2; ++n) acc[a][b][m][n] = (f32x4){0.f, 0.f, 0.f, 0.f};
    bf16x8 At[4][2], B0[2][2], B1[2][2];
    const char* cA = (const char*)g.A + (size_t)cur.pm * tstep; const char* cB = (const char*)g.Bt + (size_t)cur.pn * tstep;
    S.a_ready(cur);
    if constexpr (SP2) {
        PG8_STAGE(PG8_SB(0, 0), cB, voffB); PG8_STAGE(PG8_SB(0, 1), cB + hstep, voffB); PG8_STAGE(PG8_SA(0, 0), cA, voffA); PG8_STAGE(PG8_SA(0, 1), cA + hstep, voffA);
        if (wr == 1) PG8_BAR;
        PG8_WAIT_V(2); PG8_BAR;
        PG8_STAGE(PG8_SB(1, 0), cB + kstep, voffB); PG8_STAGE(PG8_SA(1, 0), cA + kstep, voffA); PG8_STAGE(PG8_SB(1, 1), cB + hstep + kstep, voffB);
        PG8_WAIT_V(6); PG8_BAR;
    } else {
        PG8_STAGE(PG8_SB(0, 0), cB, voffB); PG8_STAGE(PG8_SA(0, 0), cA, voffA); PG8_STAGE(PG8_SB(0, 1), cB + hstep, voffB); PG8_STAGE(PG8_SA(0, 1), cA + hstep, voffA);
        if (wr == 1) PG8_BAR;
        PG8_WAIT_V(4); PG8_BAR;
        PG8_STAGE(PG8_SB(1, 0), cB + kstep, voffB); PG8_STAGE(PG8_SA(1, 0), cA + kstep, voffA); PG8_STAGE(PG8_SB(1, 1), cB + hstep + kstep, voffB);
        PG8_WAIT_V(6); PG8_BAR;
    }
    for (;;) {
        const bool has_next = S.next(ui + 1, nxt);
        const char* nA = has_next ? (const char*)g.A + (size_t)nxt.pm * tstep : cA; const char* nB = has_next ? (const char*)g.Bt + (size_t)nxt.pn * tstep : cB;
        for (int t = 0; t < nt; t += 2) {
            const bool last = (t == nt - 2);
            const char* a1 = cA + (size_t)(t + 1) * kstep;
            const char* a2 = last ? nA : cA + (size_t)(t + 2) * kstep; const char* b2 = last ? nB : cB + (size_t)(t + 2) * kstep;
            const char* a3 = a2 + kstep; const char* b3 = b2 + kstep;
            if (last && has_next) S.a_ready(nxt);
            if constexpr (SP2) {
            PG8_LDB(B0, 0, 0); PG8_LDB(B1, 0, 1); PG8_SCHED; PG8_LDA(At, 0, 0); PG8_STAGE(PG8_SA(1, 1), a1 + hstep, voffA);
            PG8_WAIT_V(8); PG8_WAIT_L(0); PG8_BAR; PG8_MMA(0, 0, At, B0); PG8_MMA(0, 1, At, B1); PG8_BAR; PG8_SCHED;
            PG8_LDA(At, 0, 1); PG8_STAGE(PG8_SB(0, 0), b2, voffB); PG8_STAGE(PG8_SB(0, 1), b2 + hstep, voffB); PG8_STAGE(PG8_SA(0, 0), a2, voffA);
            PG8_WAIT_V(8); PG8_WAIT_L(0); PG8_BAR; PG8_MMA(1, 0, At, B0); PG8_MMA(1, 1, At, B1); PG8_BAR; PG8_SCHED;
            PG8_LDB(B0, 1, 0); PG8_LDB(B1, 1, 1); PG8_SCHED; PG8_LDA(At, 1, 0); PG8_STAGE(PG8_SA(0, 1), a2 + hstep, voffA);
            PG8_WAIT_V(8); PG8_WAIT_L(0); PG8_BAR; PG8_MMA(0, 0, At, B0); PG8_MMA(0, 1, At, B1); PG8_BAR; PG8_SCHED;
            PG8_LDA(At, 1, 1); PG8_STAGE(PG8_SB(1, 0), b3, voffB); PG8_STAGE(PG8_SB(1, 1), b3 + hstep, voffB); PG8_STAGE(PG8_SA(1, 0), a3, voffA);
            PG8_WAIT_V(8); PG8_WAIT_L(0); PG8_BAR; PG8_MMA(1, 0, At, B0); PG8_MMA(1, 1, At, B1); PG8_BAR; PG8_SCHED;
            } else {
            PG8_LDB(B0, 0, 0); PG8_SCHED; PG8_LDA(At, 0, 0); PG8_STAGE(PG8_SA(1, 1), a1 + hstep, voffA);
            PG8_WAIT_L(8); PG8_BAR; PG8_WAIT_L(0); PG8_MMA(0, 0, At, B0); PG8_BAR; PG8_SCHED;
            PG8_LDB(B1, 0, 1); PG8_STAGE(PG8_SB(0, 0), b2, voffB);
            PG8_BAR; PG8_WAIT_L(0); PG8_MMA(0, 1, At, B1); PG8_BAR;
            PG8_LDA(At, 0, 1); PG8_STAGE(PG8_SA(0, 0), a2, voffA);
            PG8_BAR; PG8_WAIT_L(0); PG8_MMA(1, 0, At, B0); PG8_BAR; PG8_SCHED;
            PG8_STAGE(PG8_SB(0, 1), b2 + hstep, voffB);
            PG8_WAIT_V(6); PG8_BAR; PG8_MMA(1, 1, At, B1); PG8_BAR;
            PG8_LDB(B0, 1, 0); PG8_SCHED; PG8_LDA(At, 1, 0); PG8_STAGE(PG8_SA(0, 1), a2 + hstep, voffA);
            PG8_WAIT_L(8); PG8_BAR; PG8_WAIT_L(0); PG8_MMA(0, 0, At, B0); PG8_BAR; PG8_SCHED;
            PG8_LDB(B1, 1, 1); PG8_STAGE(PG8_SB(1, 0), b3, voffB);
            PG8_BAR; PG8_WAIT_L(0); PG8_MMA(0, 1, At, B1); PG8_BAR;
            PG8_LDA(At, 1, 1); PG8_STAGE(PG8_SA(1, 0), a3, voffA);
            PG8_BAR; PG8_WAIT_L(0); PG8_MMA(1, 0, At, B0); PG8_BAR; PG8_SCHED;
            PG8_STAGE(PG8_SB(1, 1), b3 + hstep, voffB);
            PG8_WAIT_V(6); PG8_BAR; PG8_MMA(1, 1, At, B1); PG8_BAR;
            }
        }
        if constexpr (ALIGN_EPI) { if (wr == 0) PG8_BAR; }
        if constexpr (!Epi::AFTER_DRAIN) { E(acc, cur, wr, wc, fr, fq); S.done(cur); }
        if (!has_next) break;
#pragma unroll
        for (int a = 0; a < 2; ++a)
#pragma unroll
            for (int b = 0; b < 2; ++b)
#pragma unroll
                for (int m = 0; m < 4; ++m)
#pragma unroll
                    for (int n = 0; n < 2; ++n) acc[a][b][m][n] = (f32x4){0.f, 0.f, 0.f, 0.f};
        cur = nxt; cA = nA; cB = nB; ++ui;
        if constexpr (ALIGN_EPI) { if (wr == 1) PG8_BAR; }
    }
    PG8_WAIT_V(0);
    if constexpr (!ALIGN_EPI) { if (wr == 0) PG8_BAR; }
    PG8_BAR;
    if constexpr (Epi::AFTER_DRAIN) { E.fused(acc, cur, wr, wc, fr, fq, lds, wid, lane); S.done(cur); }
#undef PG8_SA
#undef PG8_SB
#undef PG8_STAGE
#undef PG8_LDA
#undef PG8_LDB
#undef PG8_MMA
#undef PG8_WAIT_V
#undef PG8_WAIT_L
#undef PG8_BAR
#undef PG8_SCHED
}
}
typedef GAS unsigned gu32;
typedef GAS unsigned long long gu64;
#define RLX_AGENT __ATOMIC_RELAXED, __HIP_MEMORY_SCOPE_AGENT
#define LDS_WAIT() asm volatile("s_waitcnt lgkmcnt(0)" ::: "memory")
#define VM_WAIT() asm volatile("s_waitcnt vmcnt(0)" ::: "memory")
__device__ __forceinline__ unsigned long long rt() { return __builtin_amdgcn_s_memrealtime(); }
#define XB_TMO      128
#define XB_XCNT(j)  (256  + 64 * (j))
#define XB_XSUB(j)  (1280 + 64 * (j))
#define XB_XGEN(j)  (2304 + 64 * (j))
#define XB_TOP      3328
#define XB_TOPGEN   3392
#define XCD_BAR_WORDS 3456
#define XB_SPIN_CAP (1u << 18)

__device__ __forceinline__ unsigned xb_ld(unsigned* p)              { return __hip_atomic_load(p, __ATOMIC_RELAXED, __HIP_MEMORY_SCOPE_AGENT); }
__device__ __forceinline__ unsigned xb_add(unsigned* p, unsigned v) { return __hip_atomic_fetch_add(p, v, __ATOMIC_RELAXED, __HIP_MEMORY_SCOPE_AGENT); }
__device__ __forceinline__ unsigned xb_xcc_id() { return (unsigned)__builtin_amdgcn_s_getreg((3 << 11) | 20) & 0xFu; }
#define XB_SPIN(cond, bar) do { unsigned _sp = 0; while (cond) { __builtin_amdgcn_s_sleep(1); \
    if ((++_sp & 255u) == 0u) { if (xb_ld(&(bar)[XB_TMO])) break; if (_sp > XB_SPIN_CAP) { atomicAdd(&(bar)[XB_TMO], 1u); break; } } } } while (0)

struct XcdBarrier {
    unsigned* bar; unsigned x;
    volatile LAS unsigned* st;
};

__device__ __forceinline__ XcdBarrier xcd_barrier_post(unsigned* bar, volatile LAS unsigned* st) {
    XcdBarrier b; b.bar = bar; b.x = xb_xcc_id(); b.st = st;
    if (threadIdx.x == 0) (void)xb_add(&bar[XB_XCNT(b.x)], 1u);
    return b;
}
__device__ __forceinline__ void xcd_barrier_complete(unsigned* bar, unsigned x, unsigned& nloc, unsigned& nx) {
    const unsigned G = gridDim.x * gridDim.y * gridDim.z;
    unsigned sum, cnt, mine, sp = 0u;
    for (;;) {
        sum = 0u; cnt = 0u; mine = 0u;
#pragma unroll
        for (unsigned j = 0; j < 16; ++j) { const unsigned c = xb_ld(&bar[XB_XCNT(j)]); sum += c; cnt += (c > 0u) ? 1u : 0u; mine = (j == x) ? c : mine; }
        if (sum == G) break;
        __builtin_amdgcn_s_sleep(1);
        if ((++sp & 255u) == 0u) { if (xb_ld(&bar[XB_TMO])) break; if (sp > XB_SPIN_CAP) { atomicAdd(&bar[XB_TMO], 1u); break; } }
    }
    nloc = mine > 0u ? mine : 1u; nx = cnt > 0u ? cnt : 1u;
}

__device__ __forceinline__ void xcd_barrier(const XcdBarrier& b) {
    asm volatile("s_waitcnt vmcnt(0)" ::: "memory");
    __syncthreads();
    if (threadIdx.x == 0) {
        unsigned* bar = b.bar;
        __builtin_amdgcn_s_waitcnt(0);
        unsigned nloc = b.st[0], nx = b.st[1];
        if (nloc == 0u) { xcd_barrier_complete(bar, b.x, nloc, nx); b.st[0] = nloc; b.st[1] = nx; }
        const unsigned old = xb_add(&bar[XB_XSUB(b.x)], 1u);
        const unsigned gen = old / nloc;
        if (old + 1u == (gen + 1u) * nloc) {
            __builtin_amdgcn_fence(__ATOMIC_RELEASE, "agent");
            asm volatile("s_waitcnt vmcnt(0)" ::: "memory");
            const unsigned og = xb_add(&bar[XB_TOP], 1u);
            const unsigned tg = og / nx;
            if (og + 1u == (tg + 1u) * nx) xb_add(&bar[XB_TOPGEN], 1u);
            else XB_SPIN(xb_ld(&bar[XB_TOPGEN]) == tg, bar);
            __builtin_amdgcn_fence(__ATOMIC_ACQUIRE, "agent");
            xb_add(&bar[XB_XGEN(b.x)], 1u);
            asm volatile("s_waitcnt vmcnt(0)" ::: "memory");
        } else {
            XB_SPIN(xb_ld(&bar[XB_XGEN(b.x)]) == gen, bar);
            __builtin_amdgcn_fence(__ATOMIC_ACQUIRE, "agent");
            asm volatile("s_waitcnt vmcnt(0)" ::: "memory");
        }
    }
    __syncthreads();
}
constexpr int NWAVES = 8;
constexpr int LDS_BYTES = 147456;
constexpr int RING_BYTES = 131072;
constexpr int MISC_OFF = RING_BYTES + 320;
constexpr int CW_BAR = 4096;

struct Args { const float* in[N_IN]; float* out; unsigned char* ws; int ph_lo, ph_hi; };
struct Frame {
    LAS unsigned char* lds;
    const float* const* in; float* out; unsigned char* ws;
    int tid, lane, wave, vcu, G;
};

__device__ __forceinline__ void p0_transpose_item(const float* W, int K, int N, bf16* WT, LAS float* scr, int item, int lane) {
    const int nblk = N / 32, kb = item / nblk, nb = item % nblk, k0 = 64 * kb, n0 = 32 * nb;
#pragma unroll 8
    for (int i = 0; i < 32; ++i) { const int kk = 2 * i + (lane >> 5); scr[kk * 33 + (lane & 31)] = W[(size_t)(k0 + kk) * N + n0 + (lane & 31)]; }
    LDS_WAIT(); asm volatile("" ::: "memory");
    const int c = lane & 7;
#pragma unroll
    for (int j = 0; j < 4; ++j) { const int n = (lane >> 3) + 8 * j; const LAS float* s = scr + (8 * c) * 33 + n;
        v4u o; o.x = pk2(s[0 * 33], s[1 * 33]); o.y = pk2(s[2 * 33], s[3 * 33]); o.z = pk2(s[4 * 33], s[5 * 33]); o.w = pk2(s[6 * 33], s[7 * 33]);
        *(GAS v4u*)(WT + (size_t)(n0 + n) * K + k0 + 8 * c) = o; }
    LDS_WAIT(); asm volatile("" ::: "memory");
}
struct WMat { const float* src; bf16* dst; int K, N; };
__device__ __forceinline__ WMat wmat(const Frame& F, int mi) {
    WMat w; const int pr = mi >> 1, idx = mi & 1;
    if (mi < 10) {
        if (pr == 0)      { w.K = 1024; w.N = 1280; w.src = F.in[I_WINE]  + (size_t)idx * 1024 * 1280; w.dst = (bf16*)(F.ws + WS_WINE)  + (size_t)idx * 1280 * 1024; }
        else if (pr == 1) { w.K = 1024; w.N = 1024; w.src = F.in[I_WOUTE] + (size_t)idx * 1024 * 1024; w.dst = (bf16*)(F.ws + WS_WOUTE) + (size_t)idx * 1024 * 1024; }
        else if (pr == 2) { w.K = 512;  w.N = 512;  w.src = F.in[I_WGLU]  + (size_t)idx * 512 * 512;   w.dst = (bf16*)(F.ws + WS_WGLU)  + (size_t)idx * 512 * 512; }
        else if (pr == 3) { w.K = 1024; w.N = 4096; w.src = F.in[I_WINO]  + (size_t)idx * 1024 * 4096; w.dst = (bf16*)(F.ws + WS_WINO)  + (size_t)idx * 4096 * 1024; }
        else              { w.K = 1024; w.N = 1024; w.src = F.in[I_WOUTO] + (size_t)idx * 1024 * 1024; w.dst = (bf16*)(F.ws + WS_WOUTO) + (size_t)idx * 1024 * 1024; }
    } else if (mi < 14) { const int l = mi - 10; w.K = 1024; w.N = 4096; w.src = F.in[I_WUP] + (size_t)l * 1024 * 4096; w.dst = (bf16*)(F.ws + WS_WUP) + (size_t)l * 4096 * 1024; }
    else                { const int l = mi - 14; w.K = 4096; w.N = 1024; w.src = F.in[I_WDN] + (size_t)l * 4096 * 1024; w.dst = (bf16*)(F.ws + WS_WDN) + (size_t)l * 1024 * 4096; }
    return w;
}
__device__ __forceinline__ void rms_row_to_bf16(const f32x4 (&v)[4], const float* w, bf16* orow, int lane) {
    float s2 = 0.f;
#pragma unroll
    for (int j = 0; j < 4; ++j) s2 += (v[j].x * v[j].x + v[j].y * v[j].y) + (v[j].z * v[j].z + v[j].w * v[j].w);
    const float rstd = 1.0f / sqrtf(wave_sum(s2) * (1.f / DM) + RMS_EPS);
    GAS unsigned long long* o8 = (GAS unsigned long long*)orow + lane;
#pragma unroll
    for (int j = 0; j < 4; ++j) { const f32x4 ww = *((const GAS f32x4*)w + lane + 64 * j);
        o8[64 * j] = (unsigned long long)pk2(v[j].x * rstd * ww.x, v[j].y * rstd * ww.y) | ((unsigned long long)pk2(v[j].z * rstd * ww.z, v[j].w * rstd * ww.w) << 32); }
}
__device__ __forceinline__ void p0_prologue(const Frame& F) {
    LAS float* scr = (LAS float*)(F.lds + F.wave * 16384);
    const int gw = F.vcu * NWAVES + F.wave, NGW = F.G * NWAVES;
    for (int it = gw; it < 24064; it += NGW) {
        int r = it, mi = 0;
        for (;; ++mi) { const int pr = mi >> 1; const int cnt = (mi < 10) ? (pr == 0 ? 640 : pr == 1 ? 512 : pr == 2 ? 128 : pr == 3 ? 2048 : 512) : 2048; if (r < cnt) break; r -= cnt; }
        const WMat w = wmat(F, mi);
        p0_transpose_item(w.src, w.K, w.N, w.dst, scr, r, F.lane);
    }
    bf16* XN = (bf16*)(F.ws + WS_XN);
    for (int m = gw; m < MT; m += NGW) {
        const float* xrow = (m < TP) ? F.in[I_XP] + (size_t)m * DM : F.in[I_XS] + (size_t)(m - TP) * DM;
        const GAS f32x4* xr = (const GAS f32x4*)xrow + F.lane; GAS f32x4* xo = (GAS f32x4*)(F.out + (size_t)m * DM) + F.lane;
        f32x4 v[4];
#pragma unroll
        for (int j = 0; j < 4; ++j) { v[j] = xr[64 * j]; xo[64 * j] = v[j]; }
        rms_row_to_bf16(v, F.in[I_NMIXPRE], XN + (size_t)m * DM, F.lane);
    }
}
__device__ __forceinline__ void norm_res_phase(const Frame& F, const float* w_post, const float* w_next) {
    const int gw = F.vcu * NWAVES + F.wave, NGW = F.G * NWAVES;
    bf16* XN = (bf16*)(F.ws + WS_XN); const float* MIX = (const float*)(F.ws + WS_MIX);
    for (int m = gw; m < MT; m += NGW) {
        const GAS f32x4* mr = (const GAS f32x4*)(MIX + (size_t)m * DM) + F.lane; GAS f32x4* xo = (GAS f32x4*)(F.out + (size_t)m * DM) + F.lane;
        f32x4 h[4], v[4]; float s2 = 0.f;
#pragma unroll
        for (int j = 0; j < 4; ++j) { h[j] = mr[64 * j]; v[j] = xo[64 * j]; s2 += (h[j].x * h[j].x + h[j].y * h[j].y) + (h[j].z * h[j].z + h[j].w * h[j].w); }
        const float rstd = 1.0f / sqrtf(wave_sum(s2) * (1.f / DM) + RMS_EPS);
#pragma unroll
        for (int j = 0; j < 4; ++j) { const f32x4 ww = *((const GAS f32x4*)w_post + F.lane + 64 * j); v[j] = v[j] + h[j] * rstd * ww; xo[64 * j] = v[j]; }
        if (w_next) rms_row_to_bf16(v, w_next, XN + (size_t)m * DM, F.lane);
    }
}
__device__ __forceinline__ float gelu_tanh(float y) { const float z2 = 1.5957691216f * (y + 0.044715f * y * y * y); return y / (1.0f + __expf(-z2)); }
template <int MODE>
__device__ __forceinline__ void s5_unit(const Frame& F, int idx, int g, int cu, LAS unsigned char* himg) {
    const int lane = F.lane, j = lane & 31, half = lane >> 5;
    const bf16* PROJ = (const bf16*)(F.ws + WS_PROJ);
    float ar[2], ai[2]; bf16x8 Bf[4];
    const float dt = expf(F.in[I_LSTEP][idx * S5G + g]);
#pragma unroll
    for (int s = 0; s < 2; ++s) {
        const int p = j + 32 * s; const size_t gp = (size_t)(idx * S5G + g) * S5P + p;
        const float lr = F.in[I_LRE][gp], li = F.in[I_LIM][gp];
        const float mag = expf(lr * dt), ang = li * dt; float sn, cs; sincosf(ang, &sn, &cs);
        ar[s] = mag * cs; ai[s] = mag * sn;
        const float den = lr * lr + li * li, nr = ar[s] - 1.0f;
        const float cre = (nr * lr + ai[s] * li) / den, cim = (ai[s] * lr - nr * li) / den;
        const float* bre = F.in[I_BRE] + gp * S5C + 8 * half; const float* bim = F.in[I_BIM] + gp * S5C + 8 * half;
#pragma unroll
        for (int jj = 0; jj < 8; ++jj) { const float br = bre[jj], bi = bim[jj]; Bf[2 * s][jj] = (short)f2bf(cre * br - cim * bi); Bf[2 * s + 1][jj] = (short)f2bf(cre * bi + cim * br); }
    }
    bf16x8 Cf[4];
    if (MODE != 0) {
        const int c = lane & 15, q = lane >> 4; const float* cre = F.in[I_CRE] + ((size_t)(idx * S5G + g) * S5C + c) * S5P; const float* cim = F.in[I_CIM] + ((size_t)(idx * S5G + g) * S5C + c) * S5P;
#pragma unroll
        for (int ks = 0; ks < 4; ++ks)
#pragma unroll
            for (int jj = 0; jj < 8; ++jj) { const int k = 32 * ks + 8 * q + jj, p = (k >> 2) + 32 * ((k >> 1) & 1); Cf[ks][jj] = (short)f2bf((k & 1) ? -cim[p] : cre[p]); }
    }
    float hr[2] = {0.f, 0.f}, hi[2] = {0.f, 0.f};
    if (MODE == 1 && cu > 0) {
        float pr[2], pi[2];
#pragma unroll
        for (int s = 0; s < 2; ++s) { float xr = ar[s], xi = ai[s];
#pragma unroll
            for (int k = 0; k < 7; ++k) { const float nr = xr * xr - xi * xi, ni = 2.f * xr * xi; xr = nr; xi = ni; }
            pr[s] = xr; pi[s] = xi; }
        const float2* E = (const float2*)(F.ws + WS_S5E) + ((size_t)(half * S5G + g) * 64) * S5P + j;
        for (int c = 0; c < cu; ++c) {
#pragma unroll
            for (int s = 0; s < 2; ++s) { const float2 e = E[(size_t)c * S5P + 32 * s]; const float nr = pr[s] * hr[s] - pi[s] * hi[s] + e.x, ni = pr[s] * hi[s] + pi[s] * hr[s] + e.y; hr[s] = nr; hi[s] = ni; }
        }
    }
    const int arow_half = (j >> 2) & 1, arow_r = (j & 3) + 4 * (j >> 3);
    for (int tile = 0; tile < 8; ++tile) {
#define S5_ROW(hh, r) ((MODE == 2) ? (TP + (((cu * 8 + tile) * 8 + (hh) * 4 + ((r) >> 2)) * 4) + ((r) & 3)) : ((hh) * SEQ + cu * 128 + tile * 16 + (r)))
        const size_t arow = (size_t)S5_ROW(arow_half, arow_r);
        const bf16x8 af = *(const bf16x8*)(PROJ + arow * EVEN_IN + g * S5C + 8 * half);
        f32x16 acc[4];
#pragma unroll
        for (int tl = 0; tl < 4; ++tl) { f32x16 z;
#pragma unroll
            for (int e = 0; e < 16; ++e) z[e] = 0.f;
            acc[tl] = __builtin_amdgcn_mfma_f32_32x32x16_bf16(af, Bf[tl], z, 0, 0, 0); }
#pragma unroll
        for (int r = 0; r < 16; ++r) {
            if (MODE == 2 && (r & 3) == 0) {
                const int seq = (cu * 8 + tile) * 8 + half * 4 + (r >> 2); const size_t so = ((size_t)(idx * DECB + seq) * S5G + g) * S5P + j;
                hr[0] = F.in[I_SRE][so]; hr[1] = F.in[I_SRE][so + 32]; hi[0] = F.in[I_SIM][so]; hi[1] = F.in[I_SIM][so + 32];
            }
#pragma unroll
            for (int s = 0; s < 2; ++s) { const float nr = ar[s] * hr[s] - ai[s] * hi[s] + acc[2 * s][r], ni = ar[s] * hi[s] + ai[s] * hr[s] + acc[2 * s + 1][r]; hr[s] = nr; hi[s] = ni; acc[2 * s][r] = nr; acc[2 * s + 1][r] = ni; }
            if (MODE == 2 && (r & 3) == 3) {
                const int seq = (cu * 8 + tile) * 8 + half * 4 + (r >> 2); const size_t so = ((size_t)(idx * DECB + seq) * S5G + g) * S5P + j;
                F.out[O_RES + so] = hr[0]; F.out[O_RES + so + 32] = hr[1]; F.out[O_IMS + so] = hi[0]; F.out[O_IMS + so + 32] = hi[1];
            }
            if (MODE != 0) { v2u w; w.x = pk2(acc[0][r], acc[1][r]); w.y = pk2(acc[2][r], acc[3][r]); *(LAS v2u*)(himg + (half * 16 + r) * 272 + 8 * j) = w; }
        }
        if (MODE != 0) {
            LDS_WAIT();
            const int tok = lane & 15, q = lane >> 4;
#pragma unroll
            for (int bh = 0; bh < 2; ++bh) {
                f32x4 y = (f32x4){0.f, 0.f, 0.f, 0.f};
#pragma unroll
                for (int ks = 0; ks < 4; ++ks) { const bf16x8 hb = *(const LAS bf16x8*)(himg + (bh * 16 + tok) * 272 + ks * 64 + q * 16); y = __builtin_amdgcn_mfma_f32_16x16x32_bf16(Cf[ks], hb, y, 0, 0, 0); }
                const size_t row = (size_t)S5_ROW(bh, tok);
                const v2u uw = *(const v2u*)(PROJ + row * EVEN_IN + g * S5C + 4 * q);
                const f32x4 dsk = *(const f32x4*)(F.in[I_S5D] + idx * S5W + g * S5C + 4 * q);
                const float o0 = gelu_tanh(y[0] + dsk[0] * bflo(uw.x)), o1 = gelu_tanh(y[1] + dsk[1] * bfhi(uw.x)), o2 = gelu_tanh(y[2] + dsk[2] * bflo(uw.y)), o3 = gelu_tanh(y[3] + dsk[3] * bfhi(uw.y));
                v2u ow; ow.x = pk2(o0, o1); ow.y = pk2(o2, o3);
                *(v2u*)((bf16*)(F.ws + WS_G) + row * S5W + g * S5C + 4 * q) = ow;
            }
            LDS_WAIT();
        }
#undef S5_ROW
    }
    if (MODE == 0) { float2* E = (float2*)(F.ws + WS_S5E) + ((size_t)(half * S5G + g) * 64 + cu) * S5P + j; E[0] = make_float2(hr[0], hi[0]); E[32] = make_float2(hr[1], hi[1]); }
    if (MODE == 1 && cu == 63) { const size_t so = ((size_t)(idx * NB + half) * S5G + g) * S5P + j; F.out[O_REP + so] = hr[0]; F.out[O_REP + so + 32] = hr[1]; F.out[O_IMP + so] = hi[0]; F.out[O_IMP + so + 32] = hi[1]; }
}
__device__ __forceinline__ int t5_bucket(int n) {
    if (n < 16) return n;
    int b = 16 + (int)(logf((float)n / 16.0f) / 2.0794415416798357f * 16.0f);
    return b < 31 ? b : 31;
}
constexpr int SWA_KI = 0, SWA_VT = 36864, SWA_BIAS = 36864 + 33280;
__device__ __forceinline__ void swa_prompt_unit(const Frame& F, int idx, int unit) {
    const int b = unit >> 7, nb = (unit >> 1) & 63, kvh = unit & 1;
    LAS unsigned char* KI = F.lds + SWA_KI; LAS unsigned char* VT = F.lds + SWA_VT; LAS float* BIAS = (LAS float*)(F.lds + SWA_BIAS);
    const bf16* PROJ = (const bf16*)(F.ws + WS_PROJ);
    const int tid = F.tid, lane = F.lane, wave = F.wave;
#pragma unroll
    for (int it = 0; it < 4; ++it) {
        const int cidx = tid + 512 * it, key = cidx >> 3, ch = cidx & 7; const int kpos = (nb - 1) * 128 + key;
        v4u kw = (v4u){0u, 0u, 0u, 0u}, vw = (v4u){0u, 0u, 0u, 0u};
        if (kpos >= 0) { const bf16* src = PROJ + (size_t)(b * SEQ + kpos) * EVEN_IN + 1024 + kvh * 64 + ch * 8; kw = *(const v4u*)src; vw = *(const v4u*)(src + 128); }
        *(LAS v4u*)(KI + key * 144 + ch * 16) = kw;
        const unsigned vv[4] = {vw.x, vw.y, vw.z, vw.w};
#pragma unroll
        for (int e = 0; e < 4; ++e) { *(LAS bf16*)(VT + (ch * 8 + 2 * e) * 520 + key * 2) = (bf16)(vv[e] & 0xffffu); *(LAS bf16*)(VT + (ch * 8 + 2 * e + 1) * 520 + key * 2) = (bf16)(vv[e] >> 16); }
        if (nb == 63 && key >= 128) {
            const size_t oo = (((size_t)(idx * NB + b) * 128 + (key - 128)) * 2 + kvh) * 64 + ch * 8;
            const unsigned kk[4] = {kw.x, kw.y, kw.z, kw.w};
#pragma unroll
            for (int e = 0; e < 4; ++e) { F.out[O_KP + oo + 2 * e] = bflo(kk[e]); F.out[O_KP + oo + 2 * e + 1] = bfhi(kk[e]); F.out[O_VP + oo + 2 * e] = bflo(vv[e]); F.out[O_VP + oo + 2 * e + 1] = bfhi(vv[e]); }
        }
    }
    { const int hh = tid >> 7, dist = tid & 127; BIAS[tid] = F.in[I_T5][t5_bucket(dist) * SWH + kvh * 4 + hh]; }
    __syncthreads();
    const int q = lane & 31, h = lane >> 5, hh = wave >> 1, head = kvh * 4 + hh;
    const float sink = F.in[I_SINK][idx * SWH + head];
    for (int iu = 0; iu < 2; ++iu) {
        const int i = 2 * (wave & 1) + iu;
        const size_t qrow = (size_t)(b * SEQ + nb * 128 + 32 * i + q);
        bf16x8 Qf[4];
#pragma unroll
        for (int ks = 0; ks < 4; ++ks) Qf[ks] = *(const bf16x8*)(PROJ + qrow * EVEN_IN + 512 + head * 64 + 16 * ks + 8 * h);
        f32x16 S[5];
#pragma unroll
        for (int tl = 0; tl < 5; ++tl) {
#pragma unroll
            for (int e = 0; e < 16; ++e) S[tl][e] = 0.f;
#pragma unroll
            for (int ks = 0; ks < 4; ++ks) { const bf16x8 kf = *(const LAS bf16x8*)(KI + (32 * (i + tl) + q) * 144 + (16 * ks + 8 * h) * 2); S[tl] = __builtin_amdgcn_mfma_f32_32x32x16_bf16(kf, Qf[ks], S[tl], 0, 0, 0); }
        }
        const int t = 32 * i + q; float mx = -1e30f;
#pragma unroll
        for (int tl = 0; tl < 5; ++tl)
#pragma unroll
            for (int r = 0; r < 16; ++r) { const int m = 32 * (i + tl) + (r & 3) + 8 * (r >> 2) + 4 * h; const int dist = 128 + t - m;
                const bool valid = (dist >= 0) && (dist < 128) && (nb > 0 || m >= 128);
                const float sv = valid ? S[tl][r] * 0.125f + BIAS[hh * 128 + (dist & 127)] : -1e30f; S[tl][r] = sv; mx = fmaxf(mx, sv); }
        mx = fmaxf(mx, __shfl_xor(mx, 32)); const float M = fmaxf(mx, sink); float sum = 0.f;
#pragma unroll
        for (int tl = 0; tl < 5; ++tl)
#pragma unroll
            for (int r = 0; r < 16; ++r) { const float p = __expf(S[tl][r] - M); S[tl][r] = p; sum += p; }
        sum += __shfl_xor(sum, 32); const float inv = 1.0f / (sum + __expf(sink - M));
        f32x16 O[2];
#pragma unroll
        for (int e = 0; e < 16; ++e) { O[0][e] = 0.f; O[1][e] = 0.f; }
#pragma unroll
        for (int tl = 0; tl < 5; ++tl)
#pragma unroll
            for (int ss = 0; ss < 2; ++ss) {
                bf16x8 pf; { const unsigned w0 = pk2(S[tl][8 * ss + 0], S[tl][8 * ss + 1]), w1 = pk2(S[tl][8 * ss + 2], S[tl][8 * ss + 3]), w2 = pk2(S[tl][8 * ss + 4], S[tl][8 * ss + 5]), w3 = pk2(S[tl][8 * ss + 6], S[tl][8 * ss + 7]);
                    pf = __builtin_bit_cast(bf16x8, (v4u){w0, w1, w2, w3}); }
#pragma unroll
                for (int dt = 0; dt < 2; ++dt) {
                    const LAS unsigned char* vp = VT + (32 * dt + q) * 520 + (32 * (i + tl) + 16 * ss + 4 * h) * 2;
                    const v2u lo = *(const LAS v2u*)vp, hi2 = *(const LAS v2u*)(vp + 16);
                    const bf16x8 vf = __builtin_bit_cast(bf16x8, (v4u){lo.x, lo.y, hi2.x, hi2.y});
                    O[dt] = __builtin_amdgcn_mfma_f32_32x32x16_bf16(vf, pf, O[dt], 0, 0, 0);
                }
            }
        bf16* orow = (bf16*)(F.ws + WS_CAT) + qrow * DM + 512 + head * 64;
#pragma unroll
        for (int dt = 0; dt < 2; ++dt)
#pragma unroll
            for (int rg = 0; rg < 4; ++rg) { v2u w; w.x = pk2(O[dt][4 * rg] * inv, O[dt][4 * rg + 1] * inv); w.y = pk2(O[dt][4 * rg + 2] * inv, O[dt][4 * rg + 3] * inv); *(v2u*)(orow + 32 * dt + 8 * rg + 4 * h) = w; }
    }
    __syncthreads();
}
constexpr int SWS_K = 0, SWS_V = 34320, SWS_Q = 34320 + 33792, SWS_S = SWS_Q + 4096, SWS_BIAS = SWS_S + 8704;
__device__ __forceinline__ void swa_sample_unit(const Frame& F, int idx, int unit) {
    const int b = unit >> 1, kvh = unit & 1, tid = F.tid, lane = F.lane, wave = F.wave;
    LAS float* Ks = (LAS float*)(F.lds + SWS_K); LAS float* Vs = (LAS float*)(F.lds + SWS_V); LAS float* Qs = (LAS float*)(F.lds + SWS_Q); LAS float* Ss = (LAS float*)(F.lds + SWS_S); LAS float* BIAS = (LAS float*)(F.lds + SWS_BIAS);
    const bf16* PROJ = (const bf16*)(F.ws + WS_PROJ);
    for (int e = tid; e < 132 * 64; e += 512) {
        const int jk = e >> 6, d = e & 63; float kv, vv;
        if (jk < 128) { const size_t co = (((size_t)(idx * DECB + b) * 128 + jk) * 2 + kvh) * 64 + d; kv = F.in[I_CK][co]; vv = F.in[I_CV][co]; }
        else { const bf16* src = PROJ + (size_t)(TP + 4 * b + (jk - 128)) * EVEN_IN + 1024 + kvh * 64 + d; kv = bf2f(src[0]); vv = bf2f(src[128]); }
        Ks[jk * 65 + d] = kv; Vs[jk * 64 + d] = vv;
        if (jk >= 4) { const size_t oo = (((size_t)(idx * DECB + b) * 128 + (jk - 4)) * 2 + kvh) * 64 + d; F.out[O_KS + oo] = kv; F.out[O_VS + oo] = vv; }
    }
    for (int e = tid; e < 1024; e += 512) { const int rq = e >> 6, d = e & 63, i = rq >> 2, hh = rq & 3; Qs[e] = bf2f(PROJ[(size_t)(TP + 4 * b + i) * EVEN_IN + 512 + (kvh * 4 + hh) * 64 + d]); }
    { const int hh = tid >> 7, dist = tid & 127; BIAS[tid] = F.in[I_T5][t5_bucket(dist) * SWH + kvh * 4 + hh]; }
    __syncthreads();
    for (int pidx = tid; pidx < 16 * 132; pidx += 512) {
        const int rq = pidx / 132, jk = pidx - rq * 132, i = rq >> 2, hh = rq & 3; float dot = 0.f;
#pragma unroll 8
        for (int d = 0; d < 64; ++d) dot += Qs[rq * 64 + d] * Ks[jk * 65 + d];
        const int dist = 128 + i - jk; const bool valid = dist >= 0 && dist < 128;
        Ss[rq * 136 + jk] = valid ? dot * 0.125f + BIAS[hh * 128 + (dist & 127)] : -1e30f;
    }
    __syncthreads();
#pragma unroll
    for (int rr = 0; rr < 2; ++rr) {
        const int rq = 2 * wave + rr, hh = rq & 3; const float sink = F.in[I_SINK][idx * SWH + kvh * 4 + hh];
        const float s0 = Ss[rq * 136 + lane], s1 = Ss[rq * 136 + 64 + lane], s2 = (lane < 4) ? Ss[rq * 136 + 128 + lane] : -1e30f;
        float mx = fmaxf(fmaxf(s0, s1), s2);
#pragma unroll
        for (int o = 1; o < 64; o <<= 1) mx = fmaxf(mx, __shfl_xor(mx, o));
        const float M = fmaxf(mx, sink); const float p0 = __expf(s0 - M), p1 = __expf(s1 - M), p2 = __expf(s2 - M);
        const float inv = 1.0f / (wave_sum(p0 + p1 + p2) + __expf(sink - M));
        Ss[rq * 136 + lane] = p0 * inv; Ss[rq * 136 + 64 + lane] = p1 * inv; if (lane < 4) Ss[rq * 136 + 128 + lane] = p2 * inv;
    }
    __syncthreads();
    for (int e = tid; e < 1024; e += 512) {
        const int rq = e >> 6, d = e & 63, i = rq >> 2, hh = rq & 3; float o = 0.f;
        for (int jk = 0; jk < 132; ++jk) o += Ss[rq * 136 + jk] * Vs[jk * 64 + d];
        ((bf16*)(F.ws + WS_CAT))[(size_t)(TP + 4 * b + i) * DM + 512 + (kvh * 4 + hh) * 64 + d] = (bf16)f2bf(o);
    }
    __syncthreads();
}
__device__ __forceinline__ float hgrn_lb(const Frame& F, int idx, int c) {
    if (idx == 0) return 0.f;
    const float p0 = F.in[I_LB][c], p1 = F.in[I_LB][1024 + c], m = fmaxf(p0, p1), e0 = expf(p0 - m), e1 = expf(p1 - m), s = e0 + e1, s0 = e0 / s, s1 = e1 / s;
    return (s0 + s1) - s0;
}
__device__ __forceinline__ void hgrn_gate(float z, float lb, float& logf_, float& kf) {
    z = fminf(fmaxf(z, -80.f), 80.f);
    const float ez = __expf(-z), sig = 1.0f / (1.0f + ez);
    logf_ = __logf(fmaxf(lb, 1e-30f) + (1.0f - lb) * sig);
    kf = (1.0f - lb) * (ez * sig);
}
constexpr int HG_QI = 0, HG_KI = 17408, HG_KT = 34816, HG_VT = 53248, HG_SI = 71680, HG_RED = 106496, HG_BM = 108544, HG_BL = 109056, HG_NRM = 109568;
template <bool FULL>
__device__ __forceinline__ void hgrn_prompt_unit(const Frame& F, int idx, int unit) {
    const int bh = unit / NSC, sc = unit % NSC, b = bh >> 3, h = bh & 7;
    const int tid = F.tid, lane = F.lane, wave = F.wave, d = tid & 127, sq = tid >> 7, l31 = lane & 31, hl = lane >> 5;
    LAS unsigned char* L = F.lds;
    LAS float* RED = (LAS float*)(L + HG_RED); LAS float* BM = (LAS float*)(L + HG_BM); LAS float* BL = (LAS float*)(L + HG_BL); LAS float* NRM = (LAS float*)(L + HG_NRM);
    const bf16* PROJ = (const bf16*)(F.ws + WS_PROJ);
    const float lb = hgrn_lb(F, idx, h * 128 + d);
    const int vts = wave >> 1, dts0 = 2 * (wave & 1);
    const int tt = wave & 1, vt = wave >> 1;
    f32x16 Sacc[2];
    {
        const float* S0 = (const float*)(F.ws + WS_HS) + (size_t)unit * 16384;
#pragma unroll
        for (int k = 0; k < 2; ++k)
#pragma unroll
            for (int r = 0; r < 16; ++r) { const int v = 32 * vts + (r & 3) + 8 * (r >> 2) + 4 * hl, dd = 32 * (dts0 + k) + l31; Sacc[k][r] = (FULL && sc > 0) ? S0[v * 128 + dd] : 0.f; }
    }
    float sumbl = 0.f;
    for (int ch = 0; ch < SCT / HCH; ++ch) {
        const size_t row0 = (size_t)b * SEQ + (size_t)sc * SCT + ch * HCH;
        float cum[16], kf[16], qv[16]; float run = 0.f;
#pragma unroll
        for (int e = 0; e < 16; ++e) { const bf16* pr = PROJ + (row0 + sq * 16 + e) * ODD_IN + h * 128 + d;
            float lf; hgrn_gate(bf2f(pr[1024]), lb, lf, kf[e]); run += lf; cum[e] = run;
            if (FULL) { const float qq = bf2f(pr[0]); qv[e] = qq / (1.0f + __expf(-qq)); } }
        RED[sq * 128 + d] = run;
        __syncthreads();
        const float r0 = RED[d], r1 = RED[128 + d], r2 = RED[256 + d], r3 = RED[384 + d];
        const float off = (sq > 0 ? r0 : 0.f) + (sq > 1 ? r1 : 0.f) + (sq > 2 ? r2 : 0.f), bmid = r0 + r1, blast = (r0 + r1) + (r2 + r3);
        if (sq == 0) { BM[d] = bmid; BL[d] = blast; sumbl += blast; }
        {
            unsigned kw[8];
#pragma unroll
            for (int e = 0; e < 16; e += 2) {
                const float bt0 = off + cum[e], bt1 = off + cum[e + 1];
                const float k0 = kf[e] * __expf(bmid - bt0), k1 = kf[e + 1] * __expf(bmid - bt1);
                kw[e >> 1] = pk2(k0, k1);
                if (FULL) {
                    *(LAS bf16*)(L + HG_KI + (sq * 16 + e) * 272 + d * 2) = (bf16)(kw[e >> 1] & 0xffffu); *(LAS bf16*)(L + HG_KI + (sq * 16 + e + 1) * 272 + d * 2) = (bf16)(kw[e >> 1] >> 16);
                    *(LAS bf16*)(L + HG_QI + (sq * 16 + e) * 272 + d * 2) = (bf16)f2bf(qv[e] * __expf(bt0 - bmid)); *(LAS bf16*)(L + HG_QI + (sq * 16 + e + 1) * 272 + d * 2) = (bf16)f2bf(qv[e + 1] * __expf(bt1 - bmid));
                }
            }
            *(LAS v4u*)(L + HG_KT + d * 144 + sq * 32) = (v4u){kw[0], kw[1], kw[2], kw[3]}; *(LAS v4u*)(L + HG_KT + d * 144 + sq * 32 + 16) = (v4u){kw[4], kw[5], kw[6], kw[7]};
            unsigned vw[8];
#pragma unroll
            for (int e = 0; e < 16; e += 2) { const bf16* pv = PROJ + (row0 + sq * 16 + e) * ODD_IN + 2048 + h * 128 + d; vw[e >> 1] = (unsigned)pv[0] | ((unsigned)pv[ODD_IN] << 16); }
            *(LAS v4u*)(L + HG_VT + d * 144 + sq * 32) = (v4u){vw[0], vw[1], vw[2], vw[3]}; *(LAS v4u*)(L + HG_VT + d * 144 + sq * 32 + 16) = (v4u){vw[4], vw[5], vw[6], vw[7]};
        }
        __syncthreads();
        f32x16 O;
        if (FULL) {
#pragma unroll
            for (int k = 0; k < 2; ++k) { const int dd = 32 * (dts0 + k) + l31; const float em = __expf(BM[dd]);
#pragma unroll
                for (int r = 0; r < 16; ++r) { const int v = 32 * vts + (r & 3) + 8 * (r >> 2) + 4 * hl; *(LAS bf16*)(L + HG_SI + v * 272 + dd * 2) = (bf16)f2bf(Sacc[k][r] * em); } }
            __syncthreads();
            f32x16 X[2];
#pragma unroll
            for (int st = 0; st < 2; ++st) {
#pragma unroll
                for (int e = 0; e < 16; ++e) X[st][e] = 0.f;
                if (st <= tt) {
#pragma unroll
                    for (int ks = 0; ks < 8; ++ks) { const bf16x8 a = *(const LAS bf16x8*)(L + HG_KI + (32 * st + l31) * 272 + (16 * ks + 8 * hl) * 2), bq = *(const LAS bf16x8*)(L + HG_QI + (32 * tt + l31) * 272 + (16 * ks + 8 * hl) * 2);
                        X[st] = __builtin_amdgcn_mfma_f32_32x32x16_bf16(a, bq, X[st], 0, 0, 0); }
#pragma unroll
                    for (int r = 0; r < 16; ++r) { const int s = 32 * st + (r & 3) + 8 * (r >> 2) + 4 * hl, t = 32 * tt + l31; if (s > t) X[st][r] = 0.f; }
                }
            }
#pragma unroll
            for (int e = 0; e < 16; ++e) O[e] = 0.f;
#pragma unroll
            for (int st = 0; st < 2; ++st)
                if (st <= tt) {
#pragma unroll
                    for (int ss = 0; ss < 2; ++ss) {
                        const bf16x8 pf = __builtin_bit_cast(bf16x8, (v4u){pk2(X[st][8 * ss], X[st][8 * ss + 1]), pk2(X[st][8 * ss + 2], X[st][8 * ss + 3]), pk2(X[st][8 * ss + 4], X[st][8 * ss + 5]), pk2(X[st][8 * ss + 6], X[st][8 * ss + 7])});
                        const LAS unsigned char* vp = L + HG_VT + (32 * vt + l31) * 144 + (32 * st + 16 * ss + 4 * hl) * 2;
                        const v2u lo = *(const LAS v2u*)vp, hi2 = *(const LAS v2u*)(vp + 16);
                        O = __builtin_amdgcn_mfma_f32_32x32x16_bf16(__builtin_bit_cast(bf16x8, (v4u){lo.x, lo.y, hi2.x, hi2.y}), pf, O, 0, 0, 0);
                    }
                }
#pragma unroll
            for (int ks = 0; ks < 8; ++ks) { const bf16x8 a = *(const LAS bf16x8*)(L + HG_SI + (32 * vt + l31) * 272 + (16 * ks + 8 * hl) * 2), bq = *(const LAS bf16x8*)(L + HG_QI + (32 * tt + l31) * 272 + (16 * ks + 8 * hl) * 2);
                O = __builtin_amdgcn_mfma_f32_32x32x16_bf16(a, bq, O, 0, 0, 0); }
        }
#pragma unroll
        for (int k = 0; k < 2; ++k) {
            f32x16 Dl;
#pragma unroll
            for (int e = 0; e < 16; ++e) Dl[e] = 0.f;
            const int dd = 32 * (dts0 + k) + l31;
#pragma unroll
            for (int ks = 0; ks < 4; ++ks) { const bf16x8 a = *(const LAS bf16x8*)(L + HG_VT + (32 * vts + l31) * 144 + (16 * ks + 8 * hl) * 2), bk = *(const LAS bf16x8*)(L + HG_KT + dd * 144 + (16 * ks + 8 * hl) * 2);
                Dl = __builtin_amdgcn_mfma_f32_32x32x16_bf16(a, bk, Dl, 0, 0, 0); }
            const float el = __expf(BL[dd]), ed = __expf(BL[dd] - BM[dd]);
#pragma unroll
            for (int r = 0; r < 16; ++r) Sacc[k][r] = Sacc[k][r] * el + Dl[r] * ed;
        }
        if (FULL) {
            float ssq = 0.f;
#pragma unroll
            for (int r = 0; r < 16; ++r) ssq += O[r] * O[r];
            ssq += __shfl_xor(ssq, 32);
            if (hl == 0) NRM[vt * 64 + 32 * tt + l31] = ssq;
            __syncthreads();
            const int t = 32 * tt + l31; const float tot = (NRM[t] + NRM[64 + t]) + (NRM[128 + t] + NRM[192 + t]);
            const float rstd = 1.0f / sqrtf(tot * (1.0f / HDV) + RMS_EPS);
            const size_t row = row0 + t;
#pragma unroll
            for (int rg = 0; rg < 4; ++rg) { const int v0 = 32 * vt + 8 * rg + 4 * hl;
                const v2u gw = *(const v2u*)(PROJ + row * ODD_IN + 3072 + h * 128 + v0); const f32x4 gn = *(const f32x4*)(F.in[I_GN] + idx * HDV + v0);
                const float g0 = bflo(gw.x), g1 = bfhi(gw.x), g2 = bflo(gw.y), g3 = bfhi(gw.y);
                const float o0 = O[4 * rg] * rstd * gn[0] * (g0 / (1.0f + __expf(-g0))), o1 = O[4 * rg + 1] * rstd * gn[1] * (g1 / (1.0f + __expf(-g1))), o2 = O[4 * rg + 2] * rstd * gn[2] * (g2 / (1.0f + __expf(-g2))), o3 = O[4 * rg + 3] * rstd * gn[3] * (g3 / (1.0f + __expf(-g3)));
                v2u ow; ow.x = pk2(o0, o1); ow.y = pk2(o2, o3); *(v2u*)((bf16*)(F.ws + WS_CAT) + row * DM + h * 128 + v0) = ow; }
        } else {
            __syncthreads();
        }
    }
    if (!FULL) {
        float* U = (float*)(F.ws + WS_HU) + (size_t)unit * 16384;
#pragma unroll
        for (int k = 0; k < 2; ++k)
#pragma unroll
            for (int r = 0; r < 16; ++r) { const int v = 32 * vts + (r & 3) + 8 * (r >> 2) + 4 * hl, dd = 32 * (dts0 + k) + l31; U[v * 128 + dd] = Sacc[k][r]; }
        if (sq == 0) ((float*)(F.ws + WS_HD))[(size_t)unit * 128 + d] = sumbl;
    }
    __syncthreads();
}
__device__ __forceinline__ void hgrn_carry_phase(const Frame& F, int idx) {
    const float* U = (const float*)(F.ws + WS_HU); float* HSs = (float*)(F.ws + WS_HS); const float* HD = (const float*)(F.ws + WS_HD);
    for (int e = F.vcu * 512 + F.tid; e < 16 * 16384; e += F.G * 512) {
        const int bh = e >> 14, vd = e & 16383, v = vd >> 7, dd = vd & 127; float S = 0.f;
        for (int sc = 0; sc < NSC; ++sc) { const size_t u = (size_t)(bh * NSC + sc); HSs[u * 16384 + vd] = S; S = __expf(HD[u * 128 + dd]) * S + U[u * 16384 + vd]; }
        F.out[O_HP + ((size_t)(idx * 16 + bh) * 128 + dd) * 128 + v] = S;
    }
}
constexpr int HS_QH = 0, HS_KH = 2048, HS_EL = 4096, HS_V = 4608, HS_SC = 6656, HS_NR = 6784, HS_OP = 8192;
__device__ __forceinline__ void hgrn_sample_unit(const Frame& F, int idx, int unit) {
    const int b = unit >> 3, h = unit & 7, tid = F.tid, lane = F.lane, wave = F.wave;
    LAS float* QH = (LAS float*)(F.lds + HS_QH); LAS float* KH = (LAS float*)(F.lds + HS_KH); LAS float* EL = (LAS float*)(F.lds + HS_EL); LAS float* Vs = (LAS float*)(F.lds + HS_V);
    LAS float* SC = (LAS float*)(F.lds + HS_SC); LAS float* NR = (LAS float*)(F.lds + HS_NR); LAS float* OP = (LAS float*)(F.lds + HS_OP);
    const bf16* PROJ = (const bf16*)(F.ws + WS_PROJ); const size_t row0 = (size_t)TP + 4 * b;
    if (tid < 128) {
        const int d = tid; const float lb = hgrn_lb(F, idx, h * 128 + d);
        float bt[4], kf[4], qf[4]; float run = 0.f;
#pragma unroll
        for (int t = 0; t < 4; ++t) { const bf16* pr = PROJ + (row0 + t) * ODD_IN + h * 128 + d; float lf; hgrn_gate(bf2f(pr[1024]), lb, lf, kf[t]); run += lf; bt[t] = run; const float qq = bf2f(pr[0]); qf[t] = qq / (1.0f + __expf(-qq)); Vs[t * 128 + d] = bf2f(pr[2048]); }
#pragma unroll
        for (int t = 0; t < 4; ++t) { QH[t * 128 + d] = qf[t] * __expf(bt[t]); KH[t * 128 + d] = kf[t] * __expf(bt[3] - bt[t]); }
        EL[d] = __expf(bt[3]);
#pragma unroll
        for (int t = 0; t < 4; ++t)
#pragma unroll
            for (int s = 0; s < 4; ++s) { const float pr = (s <= t) ? qf[t] * kf[s] * __expf(bt[t] - bt[s]) : 0.f; const float ws = wave_sum(pr); if (lane == 0) SC[wave * 16 + t * 4 + s] = ws; }
    }
    __syncthreads();
    {
        const int vq = tid & 31, dg = tid >> 5; const size_t so = ((size_t)(idx * DECB + b) * HH + h) * 16384;
        const float* S0 = F.in[I_SH] + so; float* SN = F.out + O_HS + so;
        f32x4 op[4];
#pragma unroll
        for (int t = 0; t < 4; ++t) op[t] = (f32x4){0.f, 0.f, 0.f, 0.f};
        f32x4 v4[4];
#pragma unroll
        for (int s = 0; s < 4; ++s) v4[s] = *(const LAS f32x4*)(Vs + s * 128 + 4 * vq);
#pragma unroll
        for (int i = 0; i < 8; ++i) {
            const int dd = dg * 8 + i; const f32x4 s4 = *(const f32x4*)(S0 + dd * 128 + 4 * vq);
            f32x4 sn = s4 * EL[dd];
#pragma unroll
            for (int s = 0; s < 4; ++s) sn += v4[s] * KH[s * 128 + dd];
            *(f32x4*)(SN + dd * 128 + 4 * vq) = sn;
#pragma unroll
            for (int t = 0; t < 4; ++t) op[t] += s4 * QH[t * 128 + dd];
        }
#pragma unroll
        for (int t = 0; t < 4; ++t) *(LAS f32x4*)(OP + (dg * 4 + t) * 128 + 4 * vq) = op[t];
    }
    __syncthreads();
    {
        const int t = tid >> 7, v = tid & 127; float o = 0.f;
#pragma unroll
        for (int dg = 0; dg < 16; ++dg) o += OP[(dg * 4 + t) * 128 + v];
#pragma unroll
        for (int s = 0; s < 4; ++s) if (s <= t) o += (SC[t * 4 + s] + SC[16 + t * 4 + s]) * Vs[s * 128 + v];
        const float ss = wave_sum(o * o); if (lane == 0) NR[wave] = ss;
        __syncthreads();
        const float tot = NR[2 * t] + NR[2 * t + 1]; const float rstd = 1.0f / sqrtf(tot * (1.0f / HDV) + RMS_EPS);
        const float gz = bf2f(PROJ[(row0 + t) * ODD_IN + 3072 + h * 128 + v]);
        ((bf16*)(F.ws + WS_CAT))[(row0 + t) * DM + h * 128 + v] = (bf16)f2bf(o * rstd * F.in[I_GN][idx * HDV + v] * (gz / (1.0f + __expf(-gz))));
    }
    __syncthreads();
}
constexpr int N_PHASES = 37;
#ifndef MK_ONE_LAUNCH
#define MK_ONE_LAUNCH 1
#endif

template <class Epi> __device__ __forceinline__ void run_gemm(const Frame& F, const bf16* A, const bf16* Bt, int N, int K, const Epi& E) {
    pg8::Gemm g{A, Bt, MT, N, K}; pg8::StaticOrder S; S.init(MT, N, F.G, (int)blockIdx.x);
    pg8::gemm_phase<Epi, pg8::StaticOrder, true, true>(F.lds, g, S, E);
}


#define PH_BAR() do { if (cur + 1 < hi) xcd_barrier(bar); } while (0)
#define PHASE(body) do { if (lo <= cur && cur < hi) { { int t_ = threadIdx.x; asm volatile("" : "+v"(t_)); F.tid = t_; F.lane = t_ & 63; F.wave = __builtin_amdgcn_readfirstlane(t_ >> 6); } body; PH_BAR(); } ++cur; } while (0)

__global__ void __launch_bounds__(NWAVES * 64, 2) mega_fwd(Args args) {
    extern __shared__ __attribute__((aligned(16))) unsigned char lds[];
    Frame F;
    F.lds = (LAS unsigned char*)lds; F.in = args.in; F.out = args.out; F.ws = args.ws;
    F.tid = threadIdx.x; F.lane = F.tid & 63; F.wave = __builtin_amdgcn_readfirstlane(F.tid >> 6);
    F.G = gridDim.x; { const int bx = blockIdx.x; F.vcu = (F.G % 8 == 0) ? (bx % 8) * (F.G / 8) + bx / 8 : bx; }
    volatile LAS unsigned* MISC = (volatile LAS unsigned*)(F.lds + MISC_OFF);
    for (int u = F.tid; u < (LDS_BYTES - RING_BYTES) / 4; u += NWAVES * 64) ((LAS unsigned*)(F.lds + RING_BYTES))[u] = 0u;
    __syncthreads();
    const int lo = args.ph_lo, hi = args.ph_hi;
    XcdBarrier bar; bar.bar = (unsigned*)(args.ws + WS_CTL) + CW_BAR; bar.x = 0; bar.st = nullptr;
    if (hi - lo > 1) bar = xcd_barrier_post((unsigned*)(args.ws + WS_CTL) + CW_BAR, MISC + 8);
    bf16* const XN = (bf16*)(F.ws + WS_XN); bf16* const CAT = (bf16*)(F.ws + WS_CAT); bf16* const G = (bf16*)(F.ws + WS_G); bf16* const PROJ = (bf16*)(F.ws + WS_PROJ); float* const MIX = (float*)(F.ws + WS_MIX);
    int cur = 0;
    PHASE(p0_prologue(F));
#pragma unroll 1
    for (int idx = 0; idx < 2; ++idx) {
        { const int l = 2 * idx;
        PHASE(run_gemm(F, XN, (const bf16*)(F.ws + WS_WINE) + (size_t)idx * EVEN_IN * DM, EVEN_IN, DM, pg8::EpiBf16<0>{PROJ, EVEN_IN}));
        PHASE({ for (int u = F.vcu; u < 256; u += F.G) swa_prompt_unit(F, idx, u);
                for (int u = F.vcu; u < 256; u += F.G) swa_sample_unit(F, idx, u);
                for (int u = F.vcu * NWAVES + F.wave; u < 2048; u += F.G * NWAVES) s5_unit<0>(F, idx, u & 31, u >> 5, F.lds + F.wave * 8704); });
        PHASE({ for (int u = F.vcu * NWAVES + F.wave; u < 2048; u += F.G * NWAVES) s5_unit<1>(F, idx, u & 31, u >> 5, F.lds + F.wave * 8704);
                for (int u = F.vcu * NWAVES + F.wave; u < 64; u += F.G * NWAVES) s5_unit<2>(F, idx, u & 31, u >> 5, F.lds + F.wave * 8704); });
        PHASE(run_gemm(F, G, (const bf16*)(F.ws + WS_WGLU) + (size_t)idx * S5W * S5W, S5W, S5W, pg8::EpiGlu{G, S5W, CAT, DM}));
        PHASE(run_gemm(F, CAT, (const bf16*)(F.ws + WS_WOUTE) + (size_t)idx * DM * DM, DM, DM, pg8::EpiF32{MIX, DM}));
        PHASE(norm_res_phase(F, F.in[I_NMIXPOST] + l * DM, F.in[I_NMLPPRE] + l * DM));
        PHASE(run_gemm(F, XN, (const bf16*)(F.ws + WS_WUP) + (size_t)l * DFF * DM, DFF, DM, pg8::EpiBf16<2>{PROJ, DFF}));
        PHASE(run_gemm(F, PROJ, (const bf16*)(F.ws + WS_WDN) + (size_t)l * DM * DFF, DM, DFF, pg8::EpiF32{MIX, DM}));
        PHASE(norm_res_phase(F, F.in[I_NMLPPOST] + l * DM, F.in[I_NMIXPRE] + (l + 1) * DM)); }
        { const int l = 2 * idx + 1;
        PHASE(run_gemm(F, XN, (const bf16*)(F.ws + WS_WINO) + (size_t)idx * ODD_IN * DM, ODD_IN, DM, pg8::EpiBf16<0>{PROJ, ODD_IN}));
        PHASE({ for (int u = F.vcu; u < 16 * NSC; u += F.G) hgrn_prompt_unit<false>(F, idx, u);
                for (int u = F.vcu; u < DECB * HH; u += F.G) hgrn_sample_unit(F, idx, u); });
        PHASE(hgrn_carry_phase(F, idx));
        PHASE({ for (int u = F.vcu; u < 16 * NSC; u += F.G) hgrn_prompt_unit<true>(F, idx, u); });
        PHASE(run_gemm(F, CAT, (const bf16*)(F.ws + WS_WOUTO) + (size_t)idx * DM * DM, DM, DM, pg8::EpiF32{MIX, DM}));
        PHASE(norm_res_phase(F, F.in[I_NMIXPOST] + l * DM, F.in[I_NMLPPRE] + l * DM));
        PHASE(run_gemm(F, XN, (const bf16*)(F.ws + WS_WUP) + (size_t)l * DFF * DM, DFF, DM, pg8::EpiBf16<2>{PROJ, DFF}));
        PHASE(run_gemm(F, PROJ, (const bf16*)(F.ws + WS_WDN) + (size_t)l * DM * DFF, DM, DFF, pg8::EpiF32{MIX, DM}));
        PHASE(norm_res_phase(F, F.in[I_NMLPPOST] + l * DM, (l < 3) ? F.in[I_NMIXPRE] + (l + 1) * DM : nullptr)); }
    }
}

extern "C" void kernel_launch(void* const* d_in, const int* in_sizes, int n_in, void* d_out, int out_size, void* d_ws, size_t ws_size, hipStream_t stream) {
    static int grid = 0;
    if (grid == 0) {
        if (n_in != N_IN || (size_t)out_size != O_END || ws_size < WS_END) { fprintf(stderr, "kernel_launch: unexpected problem (n_in %d, out %d, ws %zu); nothing launched\n", n_in, out_size, ws_size); grid = -1; return; }
        int dev = 0, cus = 0, per_cu = 0;
        if (hipGetDevice(&dev) != hipSuccess || hipDeviceGetAttribute(&cus, hipDeviceAttributeMultiprocessorCount, dev) != hipSuccess) { grid = -1; return; }
        if (hipFuncSetAttribute((const void*)mega_fwd, hipFuncAttributeMaxDynamicSharedMemorySize, LDS_BYTES) != hipSuccess) { fprintf(stderr, "kernel_launch: hipFuncSetAttribute failed\n"); grid = -1; return; }
        if (hipOccupancyMaxActiveBlocksPerMultiprocessor(&per_cu, (const void*)mega_fwd, NWAVES * 64, LDS_BYTES) != hipSuccess || per_cu < 1) { fprintf(stderr, "kernel_launch: occupancy query says %d blocks per CU\n", per_cu); }
        (void)hipGetLastError();
        grid = cus;
    }
    if (grid < 0) return;
    if (hipMemsetAsync((char*)d_ws + WS_CTL, 0, CTL_ZERO_BYTES, stream) != hipSuccess) { fprintf(stderr, "kernel_launch: memset failed\n"); return; }
    Args a{};
    for (int i = 0; i < N_IN; ++i) a.in[i] = (const float*)d_in[i];
    a.out = (float*)d_out; a.ws = (unsigned char*)d_ws;
#if MK_ONE_LAUNCH
    a.ph_lo = 0; a.ph_hi = N_PHASES;
    hipLaunchKernelGGL(mega_fwd, dim3(grid), dim3(NWAVES * 64), LDS_BYTES, stream, a);
#else
    for (int ph = 0; ph < N_PHASES; ++ph) { a.ph_lo = ph; a.ph_hi = ph + 1; hipLaunchKernelGGL(mega_fwd, dim3(grid), dim3(NWAVES * 64), LDS_BYTES, stream, a); }
#endif
    const hipError_t le = hipPeekAtLastError();
    if (le != hipSuccess) fprintf(stderr, "kernel_launch: launch failed: %s\n", hipGetErrorName(le));
}
```

```cpp
#include <hip/hip_runtime.h>
#include <cstdio>
#include <cstdint>

constexpr int DM = 1024, SEQ = 8192, NB = 2, TP = NB * SEQ, DECB = 128, DECL = 4, TS = DECB * DECL, MT = TP + TS;
constexpr int EVEN_IN = 1280, ODD_IN = 4096, DFF = 4096;
constexpr int S5G = 32, S5C = 16, S5P = 64, S5W = 512;
constexpr int SWH = 8, SWKV = 2, SWG = 4, SWD = 64, WIN = 128;
constexpr int HH = 8, HDK = 128, HDV = 128, HCH = 64;
constexpr float RMS_EPS = 1e-6f;
constexpr size_t O_Y = 0, O_KP = (size_t)MT * DM, O_VP = O_KP + 65536, O_KS = O_VP + 65536, O_VS = O_KS + 4194304, O_REP = O_VS + 4194304, O_IMP = O_REP + 8192,
                 O_RES = O_IMP + 8192, O_IMS = O_RES + 524288, O_HP = O_IMS + 524288, O_HS = O_HP + 524288, O_END = O_HS + 33554432;
enum { I_XP = 0, I_XS, I_CK, I_CV, I_SRE, I_SIM, I_SH, I_T5, I_NMIXPRE, I_NMIXPOST, I_NMLPPRE, I_NMLPPOST, I_WINE, I_WOUTE, I_LRE, I_LIM, I_LSTEP, I_BRE, I_BIM, I_CRE, I_CIM, I_S5D, I_WGLU,
       I_SINK, I_WINO, I_WOUTO, I_LB, I_GN, I_WUP, I_WDN, N_IN };
constexpr size_t MiB = 1u << 20;
constexpr size_t WS_CTL = 0, CTL_ZERO_BYTES = 1 * MiB;
constexpr size_t WS_WINE = 2 * MiB, WS_WOUTE = 7 * MiB, WS_WGLU = 11 * MiB, WS_WINO = 12 * MiB, WS_WOUTO = 28 * MiB, WS_WUP = 32 * MiB, WS_WDN = 64 * MiB;
constexpr size_t WS_XN = 96 * MiB, WS_CAT = 129 * MiB, WS_G = 162 * MiB, WS_PROJ = 179 * MiB, WS_MIX = 311 * MiB, WS_S5E = 377 * MiB, WS_HU = 379 * MiB, WS_HS = 411 * MiB, WS_HD = 443 * MiB, WS_SLAB = 444 * MiB, WS_END = 476 * MiB;
constexpr int NSC = 32, SCT = SEQ / NSC;

#define GAS __attribute__((address_space(1)))
#define LAS __attribute__((address_space(3)))
typedef unsigned short bf16;
typedef unsigned v4u __attribute__((ext_vector_type(4)));
typedef unsigned v2u __attribute__((ext_vector_type(2)));
typedef float f32x4 __attribute__((ext_vector_type(4)));
typedef float f32x16 __attribute__((ext_vector_type(16)));
typedef short bf16x8 __attribute__((ext_vector_type(8)));
typedef short s16x4 __attribute__((ext_vector_type(4)));
typedef float f32x2_t __attribute__((ext_vector_type(2))); typedef __bf16 bf16x2_t __attribute__((ext_vector_type(2)));
__device__ __forceinline__ unsigned pk2(float lo, float hi) { f32x2_t v = {lo, hi}; bf16x2_t b = __builtin_convertvector(v, bf16x2_t); return __builtin_bit_cast(unsigned, b); }
__device__ __forceinline__ unsigned f2bf(float f) { return pk2(f, 0.f) & 0xffffu; }
__device__ __forceinline__ float frcp(float x) { return __builtin_amdgcn_rcpf(x); }
__device__ __forceinline__ float fsigmoid(float x) { return __builtin_amdgcn_rcpf(1.0f + __expf(-x)); }
__device__ __forceinline__ float fsilu(float x) { return x * __builtin_amdgcn_rcpf(1.0f + __expf(-x)); }
__device__ __forceinline__ float bflo(unsigned w) { return __builtin_bit_cast(float, w << 16); }
__device__ __forceinline__ float bfhi(unsigned w) { return __builtin_bit_cast(float, w & 0xffff0000u); }
__device__ __forceinline__ float bf2f(bf16 h) { return __builtin_bit_cast(float, (unsigned)h << 16); }
__device__ __forceinline__ float wave_sum(float v) {
#pragma unroll
    for (int o = 1; o < 64; o <<= 1) v += __shfl_xor(v, o);
    return v;
}
namespace pg8 {
#define PG8_LAS __attribute__((address_space(3)))
typedef unsigned short bf16_t;
typedef short bf16x8 __attribute__((ext_vector_type(8)));
typedef float f32x4 __attribute__((ext_vector_type(4)));
typedef unsigned u32x4 __attribute__((ext_vector_type(4)));
constexpr int BM = 256, BK = 64, HALF = 128, HTB = HALF * BK * 2  , STAGE_BYTES = 8 * HTB, NXCD = 8, WGM = 8;

__host__ __device__ __forceinline__ int lds_byte(int r, int c) { const int st = (r >> 4) * 2 + (c >> 5), rr = r & 15, cc = c & 31, ob = rr * 64 + cc * 2; return st * 1024 + (ob ^ (((ob >> 9) & 1) << 5)); }
__host__ __device__ __forceinline__ void stage_rc(int b, int& R, int& C) { const int st = b / 1024, sb = b % 1024, swz = sb ^ (((sb >> 9) & 1) << 5); R = (st >> 1) * 16 + swz / 64; C = (st & 1) * 32 + (swz % 64) / 2; }
__host__ __device__ __forceinline__ int perm32(int rho) { const int n = rho >> 4, i = rho & 15; return 8 * (i >> 2) + 4 * n + (i & 3); }

struct Unit { int pm, pn, k0, nt; };
struct Gemm { const bf16_t* A; const bf16_t* Bt; int M, N, K; };

struct StaticOrder {
    int nM, nN, nwg, G, c, ntk;
    __host__ __device__ void init(int M, int N, int K, int G_, int c_) { nM = M / BM; nN = N / BM; nwg = nM * nN; G = G_; c = c_; ntk = K / BK; }
    __host__ __device__ bool next(int i, Unit& u) const {
        const long L = (long)i * G + c; if (L >= nwg) return false;
        int wgid = (int)L; { const int q = nwg / NXCD, r = nwg % NXCD, xcd = wgid % NXCD, off = wgid / NXCD; wgid = (xcd < r ? xcd * (q + 1) : r * (q + 1) + (xcd - r) * q) + off; }
        const int nig = WGM * nN, gid = wgid / nig, fm = gid * WGM, gsz = (nM - fm) < WGM ? (nM - fm) : WGM;
        u.pm = fm + ((wgid % nig) % gsz); u.pn = (wgid % nig) / gsz; u.k0 = 0; u.nt = ntk; return true;
    }
    __device__ __forceinline__ void a_ready(const Unit&) const {}
    __device__ __forceinline__ void done(const Unit&) const {}
};
struct SplitOrder {
    StaticOrder P; int S, nts, nsu;
    __host__ __device__ void init(int K, int S_, int G_, int c_) { P.init(64 * BM, 4 * BM, K, G_, c_); S = S_; nts = (K / BK) / S_; nsu = 8 * S_; }
    __host__ __device__ bool next(int i, Unit& u) const {
        const long L = (long)i * P.G + P.c;
        if (L < P.nwg) return P.next(i, u);
        const int j = (int)(L - P.nwg); if (j >= nsu) return false;
        const int sl = j >> 3, rem = j & 7; u.pm = 64 + (rem >> 2); u.pn = rem & 3; u.k0 = sl * nts; u.nt = nts; return true;
    }
    __device__ __forceinline__ void a_ready(const Unit&) const {}
    __device__ __forceinline__ void done(const Unit&) const {}
};

__device__ __forceinline__ unsigned cvt_pk_bf16(float lo, float hi) { unsigned r; asm volatile("v_cvt_pk_bf16_f32 %0, %1, %2" : "=v"(r) : "v"(lo), "v"(hi)); return r; }
struct EpiF32 {
    static constexpr bool PERM = false, AFTER_DRAIN = false;
    float* C; int ldc;
    __device__ __forceinline__ void operator()(const f32x4 (&acc)[2][2][4][2], const Unit& u, int wr, int wc, int fr, int fq) const {
        const int row0 = u.pm * BM + wr * 64 + fr, col0 = u.pn * BM + wc * 32 + 4 * fq;
#pragma unroll
        for (int ai = 0; ai < 2; ++ai)
#pragma unroll
            for (int m = 0; m < 4; ++m) { float* rowp = C + (size_t)(row0 + ai * HALF + m * 16) * ldc + col0;
#pragma unroll
                for (int bj = 0; bj < 2; ++bj)
#pragma unroll
                    for (int n = 0; n < 2; ++n) *(f32x4*)(rowp + bj * HALF + n * 16) = acc[ai][bj][m][n]; }
    }
};
template <int ACT  > struct EpiBf16 {
    static constexpr bool PERM = true, AFTER_DRAIN = false;
    bf16_t* O; int ldc;
    __device__ __forceinline__ void operator()(const f32x4 (&acc)[2][2][4][2], const Unit& u, int wr, int wc, int fr, int fq) const {
        const int row0 = u.pm * BM + wr * 64 + fr; const int col0 = u.pn * BM + wc * 32 + 8 * fq;
#pragma unroll
        for (int ai = 0; ai < 2; ++ai)
#pragma unroll
            for (int m = 0; m < 4; ++m) { bf16_t* rowp = O + (size_t)(row0 + ai * HALF + m * 16) * ldc + col0;
#pragma unroll
                for (int bj = 0; bj < 2; ++bj) { f32x4 v0 = acc[ai][bj][m][0], v1 = acc[ai][bj][m][1];
                    if (ACT == 2) {
#pragma unroll
                        for (int e = 0; e < 4; ++e) { const float a = v0[e] > 0.f ? v0[e] : 0.f, b = v1[e] > 0.f ? v1[e] : 0.f; v0[e] = a * a; v1[e] = b * b; } }
                    u32x4 w; w.x = cvt_pk_bf16(v0[0], v0[1]); w.y = cvt_pk_bf16(v0[2], v0[3]); w.z = cvt_pk_bf16(v1[0], v1[1]); w.w = cvt_pk_bf16(v1[2], v1[3]);
                    *(u32x4*)(rowp + bj * HALF) = w; } }
    }
};
struct EpiGlu {
    static constexpr bool PERM = true, AFTER_DRAIN = false;
    const bf16_t* Gm; int ldg; bf16_t* O; int ldc;
    __device__ __forceinline__ void operator()(const f32x4 (&acc)[2][2][4][2], const Unit& u, int wr, int wc, int fr, int fq) const {
        const int row0 = u.pm * BM + wr * 64 + fr; const int col0 = u.pn * BM + wc * 32 + 8 * fq;
#pragma unroll
        for (int ai = 0; ai < 2; ++ai)
#pragma unroll
            for (int m = 0; m < 4; ++m) { const size_t row = (size_t)(row0 + ai * HALF + m * 16);
#pragma unroll
                for (int bj = 0; bj < 2; ++bj) { const f32x4 v0 = acc[ai][bj][m][0], v1 = acc[ai][bj][m][1];
                    const u32x4 gw = *(const u32x4*)(Gm + row * ldg + col0 + bj * HALF);
                    float gv[8]; gv[0] = __builtin_bit_cast(float, gw.x << 16); gv[1] = __builtin_bit_cast(float, gw.x & 0xffff0000u); gv[2] = __builtin_bit_cast(float, gw.y << 16); gv[3] = __builtin_bit_cast(float, gw.y & 0xffff0000u);
                    gv[4] = __builtin_bit_cast(float, gw.z << 16); gv[5] = __builtin_bit_cast(float, gw.z & 0xffff0000u); gv[6] = __builtin_bit_cast(float, gw.w << 16); gv[7] = __builtin_bit_cast(float, gw.w & 0xffff0000u);
                    float o[8];
#pragma unroll
                    for (int e = 0; e < 4; ++e) { o[e] = gv[e] * __builtin_amdgcn_rcpf(1.0f + __expf(-v0[e])); o[4 + e] = gv[4 + e] * __builtin_amdgcn_rcpf(1.0f + __expf(-v1[e])); }
                    u32x4 w; w.x = cvt_pk_bf16(o[0], o[1]); w.y = cvt_pk_bf16(o[2], o[3]); w.z = cvt_pk_bf16(o[4], o[5]); w.w = cvt_pk_bf16(o[6], o[7]);
                    *(u32x4*)(O + row * ldc + col0 + bj * HALF) = w; } }
    }
};
struct EpiF32Split {
    static constexpr bool PERM = false, AFTER_DRAIN = false;
    float* C; int ldc; float* slab;
    __device__ __forceinline__ void operator()(const f32x4 (&acc)[2][2][4][2], const Unit& u, int wr, int wc, int fr, int fq) const {
        float* base = (u.pm < 64) ? C + (size_t)u.pm * BM * ldc : slab + ((size_t)(u.k0 / u.nt) * 512 + (size_t)(u.pm - 64) * BM) * ldc;
        const int row0 = wr * 64 + fr, col0 = u.pn * BM + wc * 32 + 4 * fq;
#pragma unroll
        for (int ai = 0; ai < 2; ++ai)
#pragma unroll
            for (int m = 0; m < 4; ++m) { float* rowp = base + (size_t)(row0 + ai * HALF + m * 16) * ldc + col0;
#pragma unroll
                for (int bj = 0; bj < 2; ++bj)
#pragma unroll
                    for (int n = 0; n < 2; ++n) *(f32x4*)(rowp + bj * HALF + n * 16) = acc[ai][bj][m][n]; }
    }
};
template <class Epi, class Sched, bool ALIGN_EPI = false, bool SP2 = false>
__device__ __forceinline__ void gemm_phase(PG8_LAS unsigned char* lds, const Gemm g, const Sched& S, const Epi& E) {
    int tid_ = threadIdx.x; asm volatile("" : "+v"(tid_));
    const int tid = tid_, wid = __builtin_amdgcn_readfirstlane(tid >> 6), lane = tid & 63, wr = wid >> 2, wc = wid & 3, fr = lane & 15, fq = lane >> 4;
    const int K = g.K;
    unsigned voffA[2], voffB[2];
#pragma unroll
    for (int i = 0; i < 2; ++i) { int R, C; stage_rc(tid * 16 + i * 8192, R, C); const int Rb = Epi::PERM ? ((R & ~31) + perm32(R & 31)) : R;
        voffA[i] = (unsigned)(R * K + C) * 2u; voffB[i] = (unsigned)(Rb * K + C) * 2u; }
    const size_t kstep = (size_t)(BK * 2);
    const size_t hstep = (size_t)HALF * K * 2;
    const size_t tstep = 2 * hstep;
    const unsigned ldsw = (unsigned)wid * 1024u;
    const int aoff = lds_byte(wr * 64 + fr, fq * 8), boff = lds_byte(wc * 32 + fr, fq * 8);
#define PG8_SA(b, h) (((b) * 2 + (h)) * HTB)
#define PG8_SB(b, h) ((4 + (b) * 2 + (h)) * HTB)
#define PG8_STAGE(bufoff, gbase, voff) do { _Pragma("unroll") for (int _i = 0; _i < 2; ++_i) \
        __builtin_amdgcn_global_load_lds((const unsigned*)((const char*)(gbase) + (voff)[_i]), (PG8_LAS unsigned*)(lds + (bufoff) + ldsw + _i * 8192), 16, 0, 0); } while (0)
#define PG8_LDA(dst, b, h) do { _Pragma("unroll") for (int m = 0; m < 4; ++m) _Pragma("unroll") for (int k = 0; k < 2; ++k) dst[m][k] = *(const PG8_LAS bf16x8*)(lds + PG8_SA(b, h) + aoff + m * 2048 + k * 1024); } while (0)
#define PG8_LDB(dst, b, h) do { _Pragma("unroll") for (int n = 0; n < 2; ++n) _Pragma("unroll") for (int k = 0; k < 2; ++k) dst[n][k] = *(const PG8_LAS bf16x8*)(lds + PG8_SB(b, h) + boff + n * 2048 + k * 1024); } while (0)
#define PG8_MMA(ai, bj, At, Bt) do { __builtin_amdgcn_s_setprio(1); _Pragma("unroll") for (int m = 0; m < 4; ++m) _Pragma("unroll") for (int n = 0; n < 2; ++n) _Pragma("unroll") for (int k = 0; k < 2; ++k) \
        acc[ai][bj][m][n] = __builtin_amdgcn_mfma_f32_16x16x32_bf16(Bt[n][k], At[m][k], acc[ai][bj][m][n], 0, 0, 0); __builtin_amdgcn_s_setprio(0); } while (0)
#define PG8_WAIT_V(n) asm volatile("s_waitcnt vmcnt(" #n ")" ::: "memory")
#define PG8_WAIT_L(n) asm volatile("s_waitcnt lgkmcnt(" #n ")" ::: "memory")
#define PG8_BAR __builtin_amdgcn_s_barrier()
#define PG8_SCHED __builtin_amdgcn_sched_barrier(0)
    Unit cur, nxt; int ui = 0;
    if (!S.next(0, cur)) return;
    f32x4 acc[2][2][4][2];
#pragma unroll
    for (int a = 0; a < 2; ++a)
#pragma unroll
        for (int b = 0; b < 2; ++b)
#pragma unroll
            for (int m = 0; m < 4; ++m)
#pragma unroll
                for (int n = 0; n < 2; ++n) acc[a][b][m][n] = (f32x4){0.f, 0.f, 0.f, 0.f};
    bf16x8 At[4][2], B0[2][2], B1[2][2];
    const char* cA = (const char*)g.A + (size_t)cur.pm * tstep + (size_t)cur.k0 * kstep; const char* cB = (const char*)g.Bt + (size_t)cur.pn * tstep + (size_t)cur.k0 * kstep;
    S.a_ready(cur);
    if constexpr (SP2) {
        PG8_STAGE(PG8_SB(0, 0), cB, voffB); PG8_STAGE(PG8_SB(0, 1), cB + hstep, voffB); PG8_STAGE(PG8_SA(0, 0), cA, voffA); PG8_STAGE(PG8_SA(0, 1), cA + hstep, voffA);
        if (wr == 1) PG8_BAR;
        PG8_WAIT_V(2); PG8_BAR;
        PG8_STAGE(PG8_SB(1, 0), cB + kstep, voffB); PG8_STAGE(PG8_SA(1, 0), cA + kstep, voffA); PG8_STAGE(PG8_SB(1, 1), cB + hstep + kstep, voffB);
        PG8_WAIT_V(6); PG8_BAR;
    } else {
        PG8_STAGE(PG8_SB(0, 0), cB, voffB); PG8_STAGE(PG8_SA(0, 0), cA, voffA); PG8_STAGE(PG8_SB(0, 1), cB + hstep, voffB); PG8_STAGE(PG8_SA(0, 1), cA + hstep, voffA);
        if (wr == 1) PG8_BAR;
        PG8_WAIT_V(4); PG8_BAR;
        PG8_STAGE(PG8_SB(1, 0), cB + kstep, voffB); PG8_STAGE(PG8_SA(1, 0), cA + kstep, voffA); PG8_STAGE(PG8_SB(1, 1), cB + hstep + kstep, voffB);
        PG8_WAIT_V(6); PG8_BAR;
    }
    for (;;) {
        const bool has_next = S.next(ui + 1, nxt);
        const char* nA = has_next ? (const char*)g.A + (size_t)nxt.pm * tstep + (size_t)nxt.k0 * kstep : cA; const char* nB = has_next ? (const char*)g.Bt + (size_t)nxt.pn * tstep + (size_t)nxt.k0 * kstep : cB;
        const int nt = cur.nt;
        for (int t = 0; t < nt; t += 2) {
            const bool last = (t == nt - 2);
            const char* a1 = cA + (size_t)(t + 1) * kstep;
            const char* a2 = last ? nA : cA + (size_t)(t + 2) * kstep; const char* b2 = last ? nB : cB + (size_t)(t + 2) * kstep;
            const char* a3 = a2 + kstep; const char* b3 = b2 + kstep;
            if (last && has_next) S.a_ready(nxt);
            if constexpr (SP2) {
            PG8_LDB(B0, 0, 0); PG8_LDB(B1, 0, 1); PG8_SCHED; PG8_LDA(At, 0, 0); PG8_STAGE(PG8_SA(1, 1), a1 + hstep, voffA);
            PG8_WAIT_V(8); PG8_WAIT_L(0); PG8_BAR; PG8_MMA(0, 0, At, B0); PG8_MMA(0, 1, At, B1); PG8_BAR; PG8_SCHED;
            PG8_LDA(At, 0, 1); PG8_STAGE(PG8_SB(0, 0), b2, voffB); PG8_STAGE(PG8_SB(0, 1), b2 + hstep, voffB); PG8_STAGE(PG8_SA(0, 0), a2, voffA);
            PG8_WAIT_V(8); PG8_WAIT_L(0); PG8_BAR; PG8_MMA(1, 0, At, B0); PG8_MMA(1, 1, At, B1); PG8_BAR; PG8_SCHED;
            PG8_LDB(B0, 1, 0); PG8_LDB(B1, 1, 1); PG8_SCHED; PG8_LDA(At, 1, 0); PG8_STAGE(PG8_SA(0, 1), a2 + hstep, voffA);
            PG8_WAIT_V(8); PG8_WAIT_L(0); PG8_BAR; PG8_MMA(0, 0, At, B0); PG8_MMA(0, 1, At, B1); PG8_BAR; PG8_SCHED;
            PG8_LDA(At, 1, 1); PG8_STAGE(PG8_SB(1, 0), b3, voffB); PG8_STAGE(PG8_SB(1, 1), b3 + hstep, voffB); PG8_STAGE(PG8_SA(1, 0), a3, voffA);
            PG8_WAIT_V(8); PG8_WAIT_L(0); PG8_BAR; PG8_MMA(1, 0, At, B0); PG8_MMA(1, 1, At, B1); PG8_BAR; PG8_SCHED;
            } else {
            PG8_LDB(B0, 0, 0); PG8_SCHED; PG8_LDA(At, 0, 0); PG8_STAGE(PG8_SA(1, 1), a1 + hstep, voffA);
            PG8_WAIT_L(8); PG8_BAR; PG8_WAIT_L(0); PG8_MMA(0, 0, At, B0); PG8_BAR; PG8_SCHED;
            PG8_LDB(B1, 0, 1); PG8_STAGE(PG8_SB(0, 0), b2, voffB);
            PG8_BAR; PG8_WAIT_L(0); PG8_MMA(0, 1, At, B1); PG8_BAR;
            PG8_LDA(At, 0, 1); PG8_STAGE(PG8_SA(0, 0), a2, voffA);
            PG8_BAR; PG8_WAIT_L(0); PG8_MMA(1, 0, At, B0); PG8_BAR; PG8_SCHED;
            PG8_STAGE(PG8_SB(0, 1), b2 + hstep, voffB);
            PG8_WAIT_V(6); PG8_BAR; PG8_MMA(1, 1, At, B1); PG8_BAR;
            PG8_LDB(B0, 1, 0); PG8_SCHED; PG8_LDA(At, 1, 0); PG8_STAGE(PG8_SA(0, 1), a2 + hstep, voffA);
            PG8_WAIT_L(8); PG8_BAR; PG8_WAIT_L(0); PG8_MMA(0, 0, At, B0); PG8_BAR; PG8_SCHED;
            PG8_LDB(B1, 1, 1); PG8_STAGE(PG8_SB(1, 0), b3, voffB);
            PG8_BAR; PG8_WAIT_L(0); PG8_MMA(0, 1, At, B1); PG8_BAR;
            PG8_LDA(At, 1, 1); PG8_STAGE(PG8_SA(1, 0), a3, voffA);
            PG8_BAR; PG8_WAIT_L(0); PG8_MMA(1, 0, At, B0); PG8_BAR; PG8_SCHED;
            PG8_STAGE(PG8_SB(1, 1), b3 + hstep, voffB);
            PG8_WAIT_V(6); PG8_BAR; PG8_MMA(1, 1, At, B1); PG8_BAR;
            }
        }
        if constexpr (ALIGN_EPI) { if (wr == 0) PG8_BAR; }
        if constexpr (!Epi::AFTER_DRAIN) { E(acc, cur, wr, wc, fr, fq); S.done(cur); }
        if (!has_next) break;
#pragma unroll
        for (int a = 0; a < 2; ++a)
#pragma unroll
            for (int b = 0; b < 2; ++b)
#pragma unroll
                for (int m = 0; m < 4; ++m)
#pragma unroll
                    for (int n = 0; n < 2; ++n) acc[a][b][m][n] = (f32x4){0.f, 0.f, 0.f, 0.f};
        cur = nxt; cA = nA; cB = nB; ++ui;
        if constexpr (ALIGN_EPI) { if (wr == 1) PG8_BAR; }
    }
    PG8_WAIT_V(0);
    if constexpr (!ALIGN_EPI) { if (wr == 0) PG8_BAR; }
    PG8_BAR;
    if constexpr (Epi::AFTER_DRAIN) { E.fused(acc, cur, wr, wc, fr, fq, lds, wid, lane); S.done(cur); }
#undef PG8_SA
#undef PG8_SB
#undef PG8_STAGE
#undef PG8_LDA
#undef PG8_LDB
#undef PG8_MMA
#undef PG8_WAIT_V
#undef PG8_WAIT_L
#undef PG8_BAR
#undef PG8_SCHED
}
}
typedef GAS unsigned gu32;
typedef GAS unsigned long long gu64;
#define RLX_AGENT __ATOMIC_RELAXED, __HIP_MEMORY_SCOPE_AGENT
#define LDS_WAIT() asm volatile("s_waitcnt lgkmcnt(0)" ::: "memory")
#define VM_WAIT() asm volatile("s_waitcnt vmcnt(0)" ::: "memory")
__device__ __forceinline__ unsigned long long rt() { return __builtin_amdgcn_s_memrealtime(); }
#define XB_TMO      128
#define XB_XCNT(j)  (256  + 64 * (j))
#define XB_XSUB(j)  (1280 + 64 * (j))
#define XB_XGEN(j)  (2304 + 64 * (j))
#define XB_TOP      3328
#define XB_TOPGEN   3392
#define XCD_BAR_WORDS 3456
#define XB_SPIN_CAP (1u << 18)

__device__ __forceinline__ unsigned xb_ld(unsigned* p)              { return __hip_atomic_load(p, __ATOMIC_RELAXED, __HIP_MEMORY_SCOPE_AGENT); }
__device__ __forceinline__ unsigned xb_add(unsigned* p, unsigned v) { return __hip_atomic_fetch_add(p, v, __ATOMIC_RELAXED, __HIP_MEMORY_SCOPE_AGENT); }
__device__ __forceinline__ unsigned xb_xcc_id() { return (unsigned)__builtin_amdgcn_s_getreg((3 << 11) | 20) & 0xFu; }
#define XB_SPIN(cond, bar) do { unsigned _sp = 0; while (cond) { __builtin_amdgcn_s_sleep(1); \
    if ((++_sp & 255u) == 0u) { if (xb_ld(&(bar)[XB_TMO])) break; if (_sp > XB_SPIN_CAP) { atomicAdd(&(bar)[XB_TMO], 1u); break; } } } } while (0)

struct XcdBarrier {
    unsigned* bar; unsigned x;
    volatile LAS unsigned* st;
};

__device__ __forceinline__ XcdBarrier xcd_barrier_post(unsigned* bar, volatile LAS unsigned* st) {
    XcdBarrier b; b.bar = bar; b.x = xb_xcc_id(); b.st = st;
    if (threadIdx.x == 0) (void)xb_add(&bar[XB_XCNT(b.x)], 1u);
    return b;
}
__device__ __forceinline__ void xcd_barrier_complete(unsigned* bar, unsigned x, unsigned& nloc, unsigned& nx) {
    const unsigned G = gridDim.x * gridDim.y * gridDim.z;
    unsigned sum, cnt, mine, sp = 0u;
    for (;;) {
        sum = 0u; cnt = 0u; mine = 0u;
#pragma unroll
        for (unsigned j = 0; j < 16; ++j) { const unsigned c = xb_ld(&bar[XB_XCNT(j)]); sum += c; cnt += (c > 0u) ? 1u : 0u; mine = (j == x) ? c : mine; }
        if (sum == G) break;
        __builtin_amdgcn_s_sleep(1);
        if ((++sp & 255u) == 0u) { if (xb_ld(&bar[XB_TMO])) break; if (sp > XB_SPIN_CAP) { atomicAdd(&bar[XB_TMO], 1u); break; } }
    }
    nloc = mine > 0u ? mine : 1u; nx = cnt > 0u ? cnt : 1u;
}

__device__ __forceinline__ void xcd_barrier(const XcdBarrier& b) {
    asm volatile("s_waitcnt vmcnt(0)" ::: "memory");
    __syncthreads();
    if (threadIdx.x == 0) {
        unsigned* bar = b.bar;
        __builtin_amdgcn_s_waitcnt(0);
        unsigned nloc = b.st[0], nx = b.st[1];
        if (nloc == 0u) { xcd_barrier_complete(bar, b.x, nloc, nx); b.st[0] = nloc; b.st[1] = nx; }
        const unsigned old = xb_add(&bar[XB_XSUB(b.x)], 1u);
        const unsigned gen = old / nloc;
        if (old + 1u == (gen + 1u) * nloc) {
            __builtin_amdgcn_fence(__ATOMIC_RELEASE, "agent");
            asm volatile("s_waitcnt vmcnt(0)" ::: "memory");
            const unsigned og = xb_add(&bar[XB_TOP], 1u);
            const unsigned tg = og / nx;
            if (og + 1u == (tg + 1u) * nx) xb_add(&bar[XB_TOPGEN], 1u);
            else XB_SPIN(xb_ld(&bar[XB_TOPGEN]) == tg, bar);
            __builtin_amdgcn_fence(__ATOMIC_ACQUIRE, "agent");
            xb_add(&bar[XB_XGEN(b.x)], 1u);
            asm volatile("s_waitcnt vmcnt(0)" ::: "memory");
        } else {
            XB_SPIN(xb_ld(&bar[XB_XGEN(b.x)]) == gen, bar);
            __builtin_amdgcn_fence(__ATOMIC_ACQUIRE, "agent");
            asm volatile("s_waitcnt vmcnt(0)" ::: "memory");
        }
    }
    __syncthreads();
}
constexpr int NWAVES = 8;
constexpr int LDS_BYTES = 147456;
constexpr int RING_BYTES = 131072;
constexpr int MISC_OFF = RING_BYTES + 320;
constexpr int CW_BAR = 4096;

struct Args { const float* in[N_IN]; float* out; unsigned char* ws; int ph_lo, ph_hi; };
struct Frame {
    LAS unsigned char* lds;
    const float* const* in; float* out; unsigned char* ws;
    int tid, lane, wave, vcu, G;
};

__device__ __forceinline__ void p0_transpose_item(const float* W, int K, int N, bf16* WT, LAS float* scr, int item, int lane) {
    const int nblk = N / 32, kb = item / nblk, nb = item % nblk, k0 = 64 * kb, n0 = 32 * nb;
#pragma unroll 8
    for (int i = 0; i < 32; ++i) { const int kk = 2 * i + (lane >> 5); scr[kk * 33 + (lane & 31)] = W[(size_t)(k0 + kk) * N + n0 + (lane & 31)]; }
    LDS_WAIT(); asm volatile("" ::: "memory");
    const int c = lane & 7;
#pragma unroll
    for (int j = 0; j < 4; ++j) { const int n = (lane >> 3) + 8 * j; const LAS float* s = scr + (8 * c) * 33 + n;
        v4u o; o.x = pk2(s[0 * 33], s[1 * 33]); o.y = pk2(s[2 * 33], s[3 * 33]); o.z = pk2(s[4 * 33], s[5 * 33]); o.w = pk2(s[6 * 33], s[7 * 33]);
        *(GAS v4u*)(WT + (size_t)(n0 + n) * K + k0 + 8 * c) = o; }
    LDS_WAIT(); asm volatile("" ::: "memory");
}
struct WMat { const float* src; bf16* dst; int K, N; };
__device__ __forceinline__ WMat wmat(const Frame& F, int mi) {
    WMat w; const int pr = mi >> 1, idx = mi & 1;
    if (mi < 10) {
        if (pr == 0)      { w.K = 1024; w.N = 1280; w.src = F.in[I_WINE]  + (size_t)idx * 1024 * 1280; w.dst = (bf16*)(F.ws + WS_WINE)  + (size_t)idx * 1280 * 1024; }
        else if (pr == 1) { w.K = 1024; w.N = 1024; w.src = F.in[I_WOUTE] + (size_t)idx * 1024 * 1024; w.dst = (bf16*)(F.ws + WS_WOUTE) + (size_t)idx * 1024 * 1024; }
        else if (pr == 2) { w.K = 512;  w.N = 512;  w.src = F.in[I_WGLU]  + (size_t)idx * 512 * 512;   w.dst = (bf16*)(F.ws + WS_WGLU)  + (size_t)idx * 512 * 512; }
        else if (pr == 3) { w.K = 1024; w.N = 4096; w.src = F.in[I_WINO]  + (size_t)idx * 1024 * 4096; w.dst = (bf16*)(F.ws + WS_WINO)  + (size_t)idx * 4096 * 1024; }
        else              { w.K = 1024; w.N = 1024; w.src = F.in[I_WOUTO] + (size_t)idx * 1024 * 1024; w.dst = (bf16*)(F.ws + WS_WOUTO) + (size_t)idx * 1024 * 1024; }
    } else if (mi < 14) { const int l = mi - 10; w.K = 1024; w.N = 4096; w.src = F.in[I_WUP] + (size_t)l * 1024 * 4096; w.dst = (bf16*)(F.ws + WS_WUP) + (size_t)l * 4096 * 1024; }
    else                { const int l = mi - 14; w.K = 4096; w.N = 1024; w.src = F.in[I_WDN] + (size_t)l * 4096 * 1024; w.dst = (bf16*)(F.ws + WS_WDN) + (size_t)l * 1024 * 4096; }
    return w;
}
__device__ __forceinline__ void rms_row_to_bf16(const f32x4 (&v)[4], const float* w, bf16* orow, int lane) {
    float s2 = 0.f;
#pragma unroll
    for (int j = 0; j < 4; ++j) s2 += (v[j].x * v[j].x + v[j].y * v[j].y) + (v[j].z * v[j].z + v[j].w * v[j].w);
    const float rstd = 1.0f / sqrtf(wave_sum(s2) * (1.f / DM) + RMS_EPS);
    GAS unsigned long long* o8 = (GAS unsigned long long*)orow + lane;
#pragma unroll
    for (int j = 0; j < 4; ++j) { const f32x4 ww = *((const GAS f32x4*)w + lane + 64 * j);
        o8[64 * j] = (unsigned long long)pk2(v[j].x * rstd * ww.x, v[j].y * rstd * ww.y) | ((unsigned long long)pk2(v[j].z * rstd * ww.z, v[j].w * rstd * ww.w) << 32); }
}
__device__ __forceinline__ void p0_prologue(const Frame& F) {
    LAS float* scr = (LAS float*)(F.lds + F.wave * 16384);
    const int gw = F.vcu * NWAVES + F.wave, NGW = F.G * NWAVES;
    for (int it = gw; it < 24064; it += NGW) {
        int r = it, mi = 0;
        for (;; ++mi) { const int pr = mi >> 1; const int cnt = (mi < 10) ? (pr == 0 ? 640 : pr == 1 ? 512 : pr == 2 ? 128 : pr == 3 ? 2048 : 512) : 2048; if (r < cnt) break; r -= cnt; }
        const WMat w = wmat(F, mi);
        p0_transpose_item(w.src, w.K, w.N, w.dst, scr, r, F.lane);
    }
    bf16* XN = (bf16*)(F.ws + WS_XN);
    for (int m = gw; m < MT; m += NGW) {
        const float* xrow = (m < TP) ? F.in[I_XP] + (size_t)m * DM : F.in[I_XS] + (size_t)(m - TP) * DM;
        const GAS f32x4* xr = (const GAS f32x4*)xrow + F.lane; GAS f32x4* xo = (GAS f32x4*)(F.out + (size_t)m * DM) + F.lane;
        f32x4 v[4];
#pragma unroll
        for (int j = 0; j < 4; ++j) { v[j] = xr[64 * j]; xo[64 * j] = v[j]; }
        rms_row_to_bf16(v, F.in[I_NMIXPRE], XN + (size_t)m * DM, F.lane);
    }
}
__device__ __forceinline__ void norm_res_phase(const Frame& F, const float* w_post, const float* w_next, int nslab) {
    const int gw = F.vcu * NWAVES + F.wave, NGW = F.G * NWAVES;
    bf16* XN = (bf16*)(F.ws + WS_XN); const float* MIX = (const float*)(F.ws + WS_MIX);
    for (int m = gw; m < MT; m += NGW) {
        const GAS f32x4* mr = (const GAS f32x4*)(MIX + (size_t)m * DM) + F.lane; GAS f32x4* xo = (GAS f32x4*)(F.out + (size_t)m * DM) + F.lane;
        f32x4 h[4], v[4]; float s2 = 0.f;
#pragma unroll
        for (int j = 0; j < 4; ++j) { h[j] = mr[64 * j]; v[j] = xo[64 * j]; }
        if (m >= TP) {
            const GAS f32x4* sr = (const GAS f32x4*)((const float*)(F.ws + WS_SLAB) + (size_t)(m - TP) * DM) + F.lane;
#pragma unroll
            for (int j = 0; j < 4; ++j) h[j] = sr[64 * j];
            for (int s = 1; s < nslab; ++s) {
#pragma unroll
                for (int j = 0; j < 4; ++j) h[j] += sr[(size_t)s * (TS * DM / 4) + 64 * j]; }
        }
#pragma unroll
        for (int j = 0; j < 4; ++j) s2 += (h[j].x * h[j].x + h[j].y * h[j].y) + (h[j].z * h[j].z + h[j].w * h[j].w);
        const float rstd = 1.0f / sqrtf(wave_sum(s2) * (1.f / DM) + RMS_EPS);
#pragma unroll
        for (int j = 0; j < 4; ++j) { const f32x4 ww = *((const GAS f32x4*)w_post + F.lane + 64 * j); v[j] = v[j] + h[j] * rstd * ww; xo[64 * j] = v[j]; }
        if (w_next) rms_row_to_bf16(v, w_next, XN + (size_t)m * DM, F.lane);
    }
}
__device__ __forceinline__ float gelu_tanh(float y) { const float z2 = 1.5957691216f * (y + 0.044715f * y * y * y); return y * frcp(1.0f + __expf(-z2)); }
template <int MODE>
__device__ __forceinline__ void s5_unit(const Frame& F, int idx, int g, int cu, LAS unsigned char* himg, int tile0 = 0, int tile1 = 8) {
    const int lane = F.lane, j = lane & 31, half = lane >> 5;
    const bf16* PROJ = (const bf16*)(F.ws + WS_PROJ);
    float ar[2], ai[2]; bf16x8 Bf[4];
    const float dt = expf(F.in[I_LSTEP][idx * S5G + g]);
#pragma unroll
    for (int s = 0; s < 2; ++s) {
        const int p = j + 32 * s; const size_t gp = (size_t)(idx * S5G + g) * S5P + p;
        const float lr = F.in[I_LRE][gp], li = F.in[I_LIM][gp];
        const float mag = expf(lr * dt), ang = li * dt; float sn, cs; sincosf(ang, &sn, &cs);
        ar[s] = mag * cs; ai[s] = mag * sn;
        const float den = lr * lr + li * li, nr = ar[s] - 1.0f;
        const float cre = (nr * lr + ai[s] * li) / den, cim = (ai[s] * lr - nr * li) / den;
        const float* bre = F.in[I_BRE] + gp * S5C + 8 * half; const float* bim = F.in[I_BIM] + gp * S5C + 8 * half;
#pragma unroll
        for (int jj = 0; jj < 8; ++jj) { const float br = bre[jj], bi = bim[jj]; Bf[2 * s][jj] = (short)f2bf(cre * br - cim * bi); Bf[2 * s + 1][jj] = (short)f2bf(cre * bi + cim * br); }
    }
    bf16x8 Cf[4];
    if (MODE != 0) {
        const int c = lane & 15, q = lane >> 4; const float* cre = F.in[I_CRE] + ((size_t)(idx * S5G + g) * S5C + c) * S5P; const float* cim = F.in[I_CIM] + ((size_t)(idx * S5G + g) * S5C + c) * S5P;
#pragma unroll
        for (int ks = 0; ks < 4; ++ks)
#pragma unroll
            for (int jj = 0; jj < 8; ++jj) { const int k = 32 * ks + 8 * q + jj, p = (k >> 2) + 32 * ((k >> 1) & 1); Cf[ks][jj] = (short)f2bf((k & 1) ? -cim[p] : cre[p]); }
    }
    float hr[2] = {0.f, 0.f}, hi[2] = {0.f, 0.f};
    if (MODE == 1 && cu > 0) {
        float pr[2], pi[2];
#pragma unroll
        for (int s = 0; s < 2; ++s) { float xr = ar[s], xi = ai[s];
#pragma unroll
            for (int k = 0; k < 7; ++k) { const float nr = xr * xr - xi * xi, ni = 2.f * xr * xi; xr = nr; xi = ni; }
            pr[s] = xr; pi[s] = xi; }
        const float2* E = (const float2*)(F.ws + WS_S5E) + ((size_t)(half * S5G + g) * 64) * S5P + j;
        for (int c = 0; c < cu; ++c) {
#pragma unroll
            for (int s = 0; s < 2; ++s) { const float2 e = E[(size_t)c * S5P + 32 * s]; const float nr = pr[s] * hr[s] - pi[s] * hi[s] + e.x, ni = pr[s] * hi[s] + pi[s] * hr[s] + e.y; hr[s] = nr; hi[s] = ni; }
        }
    }
    const int arow_half = (j >> 2) & 1, arow_r = (j & 3) + 4 * (j >> 3);
    for (int tile = tile0; tile < tile1; ++tile) {
#define S5_ROW(hh, r) ((MODE == 2) ? (TP + (((cu * 8 + tile) * 8 + (hh) * 4 + ((r) >> 2)) * 4) + ((r) & 3)) : ((hh) * SEQ + cu * 128 + tile * 16 + (r)))
        const size_t arow = (size_t)S5_ROW(arow_half, arow_r);
        const bf16x8 af = *(const bf16x8*)(PROJ + arow * EVEN_IN + g * S5C + 8 * half);
        f32x16 acc[4];
#pragma unroll
        for (int tl = 0; tl < 4; ++tl) { f32x16 z;
#pragma unroll
            for (int e = 0; e < 16; ++e) z[e] = 0.f;
            acc[tl] = __builtin_amdgcn_mfma_f32_32x32x16_bf16(af, Bf[tl], z, 0, 0, 0); }
#pragma unroll
        for (int r = 0; r < 16; ++r) {
            if (MODE == 2 && (r & 3) == 0) {
                const int seq = (cu * 8 + tile) * 8 + half * 4 + (r >> 2); const size_t so = ((size_t)(idx * DECB + seq) * S5G + g) * S5P + j;
                hr[0] = F.in[I_SRE][so]; hr[1] = F.in[I_SRE][so + 32]; hi[0] = F.in[I_SIM][so]; hi[1] = F.in[I_SIM][so + 32];
            }
#pragma unroll
            for (int s = 0; s < 2; ++s) { const float nr = ar[s] * hr[s] - ai[s] * hi[s] + acc[2 * s][r], ni = ar[s] * hi[s] + ai[s] * hr[s] + acc[2 * s + 1][r]; hr[s] = nr; hi[s] = ni; acc[2 * s][r] = nr; acc[2 * s + 1][r] = ni; }
            if (MODE == 2 && (r & 3) == 3) {
                const int seq = (cu * 8 + tile) * 8 + half * 4 + (r >> 2); const size_t so = ((size_t)(idx * DECB + seq) * S5G + g) * S5P + j;
                F.out[O_RES + so] = hr[0]; F.out[O_RES + so + 32] = hr[1]; F.out[O_IMS + so] = hi[0]; F.out[O_IMS + so + 32] = hi[1];
            }
            if (MODE != 0) { v2u w; w.x = pk2(acc[0][r], acc[1][r]); w.y = pk2(acc[2][r], acc[3][r]); *(LAS v2u*)(himg + (half * 16 + r) * 272 + 8 * j) = w; }
        }
        if (MODE != 0) {
            LDS_WAIT();
            const int tok = lane & 15, q = lane >> 4;
#pragma unroll
            for (int bh = 0; bh < 2; ++bh) {
                f32x4 y = (f32x4){0.f, 0.f, 0.f, 0.f};
#pragma unroll
                for (int ks = 0; ks < 4; ++ks) { const bf16x8 hb = *(const LAS bf16x8*)(himg + (bh * 16 + tok) * 272 + ks * 64 + q * 16); y = __builtin_amdgcn_mfma_f32_16x16x32_bf16(Cf[ks], hb, y, 0, 0, 0); }
                const size_t row = (size_t)S5_ROW(bh, tok);
                const v2u uw = *(const v2u*)(PROJ + row * EVEN_IN + g * S5C + 4 * q);
                const f32x4 dsk = *(const f32x4*)(F.in[I_S5D] + idx * S5W + g * S5C + 4 * q);
                const float o0 = gelu_tanh(y[0] + dsk[0] * bflo(uw.x)), o1 = gelu_tanh(y[1] + dsk[1] * bfhi(uw.x)), o2 = gelu_tanh(y[2] + dsk[2] * bflo(uw.y)), o3 = gelu_tanh(y[3] + dsk[3] * bfhi(uw.y));
                v2u ow; ow.x = pk2(o0, o1); ow.y = pk2(o2, o3);
                *(v2u*)((bf16*)(F.ws + WS_G) + row * S5W + g * S5C + 4 * q) = ow;
            }
            LDS_WAIT();
        }
#undef S5_ROW
    }
    if (MODE == 0) { float2* E = (float2*)(F.ws + WS_S5E) + ((size_t)(half * S5G + g) * 64 + cu) * S5P + j; E[0] = make_float2(hr[0], hi[0]); E[32] = make_float2(hr[1], hi[1]); }
    if (MODE == 1 && cu == 63) { const size_t so = ((size_t)(idx * NB + half) * S5G + g) * S5P + j; F.out[O_REP + so] = hr[0]; F.out[O_REP + so + 32] = hr[1]; F.out[O_IMP + so] = hi[0]; F.out[O_IMP + so + 32] = hi[1]; }
}
__device__ __forceinline__ int t5_bucket(int n) {
    if (n < 16) return n;
    int b = 16 + (int)(logf((float)n / 16.0f) / 2.0794415416798357f * 16.0f);
    return b < 31 ? b : 31;
}
constexpr int SWA_KI = 0, SWA_VT = 36864, SWA_BIAS = 36864 + 33280;
__device__ __forceinline__ void swa_prompt_unit(const Frame& F, int idx, int unit) {
    const int b = unit >> 7, nb = (unit >> 1) & 63, kvh = unit & 1;
    LAS unsigned char* KI = F.lds + SWA_KI; LAS unsigned char* VT = F.lds + SWA_VT; LAS float* BIAS = (LAS float*)(F.lds + SWA_BIAS);
    const bf16* PROJ = (const bf16*)(F.ws + WS_PROJ);
    const int tid = F.tid, lane = F.lane, wave = F.wave;
#pragma unroll
    for (int it = 0; it < 4; ++it) {
        const int cidx = tid + 512 * it, key = cidx >> 3, ch = cidx & 7; const int kpos = (nb - 1) * 128 + key;
        v4u kw = (v4u){0u, 0u, 0u, 0u}, vw = (v4u){0u, 0u, 0u, 0u};
        if (kpos >= 0) { const bf16* src = PROJ + (size_t)(b * SEQ + kpos) * EVEN_IN + 1024 + kvh * 64 + ch * 8; kw = *(const v4u*)src; vw = *(const v4u*)(src + 128); }
        *(LAS v4u*)(KI + key * 144 + ch * 16) = kw;
        const unsigned vv[4] = {vw.x, vw.y, vw.z, vw.w};
#pragma unroll
        for (int e = 0; e < 4; ++e) { *(LAS bf16*)(VT + (ch * 8 + 2 * e) * 520 + key * 2) = (bf16)(vv[e] & 0xffffu); *(LAS bf16*)(VT + (ch * 8 + 2 * e + 1) * 520 + key * 2) = (bf16)(vv[e] >> 16); }
        if (nb == 63 && key >= 128) {
            const size_t oo = (((size_t)(idx * NB + b) * 128 + (key - 128)) * 2 + kvh) * 64 + ch * 8;
            const unsigned kk[4] = {kw.x, kw.y, kw.z, kw.w};
#pragma unroll
            for (int e = 0; e < 4; ++e) { F.out[O_KP + oo + 2 * e] = bflo(kk[e]); F.out[O_KP + oo + 2 * e + 1] = bfhi(kk[e]); F.out[O_VP + oo + 2 * e] = bflo(vv[e]); F.out[O_VP + oo + 2 * e + 1] = bfhi(vv[e]); }
        }
    }
    { const int hh = tid >> 7, dist = tid & 127; BIAS[tid] = F.in[I_T5][t5_bucket(dist) * SWH + kvh * 4 + hh]; }
    __syncthreads();
    const int q = lane & 31, h = lane >> 5, hh = wave >> 1, head = kvh * 4 + hh;
    const float sink = F.in[I_SINK][idx * SWH + head];
    for (int iu = 0; iu < 2; ++iu) {
        const int i = 2 * (wave & 1) + iu;
        const size_t qrow = (size_t)(b * SEQ + nb * 128 + 32 * i + q);
        bf16x8 Qf[4];
#pragma unroll
        for (int ks = 0; ks < 4; ++ks) Qf[ks] = *(const bf16x8*)(PROJ + qrow * EVEN_IN + 512 + head * 64 + 16 * ks + 8 * h);
        f32x16 S[5];
#pragma unroll
        for (int tl = 0; tl < 5; ++tl) {
#pragma unroll
            for (int e = 0; e < 16; ++e) S[tl][e] = 0.f;
#pragma unroll
            for (int ks = 0; ks < 4; ++ks) { const bf16x8 kf = *(const LAS bf16x8*)(KI + (32 * (i + tl) + q) * 144 + (16 * ks + 8 * h) * 2); S[tl] = __builtin_amdgcn_mfma_f32_32x32x16_bf16(kf, Qf[ks], S[tl], 0, 0, 0); }
        }
        const int t = 32 * i + q; float mx = -1e30f;
#pragma unroll
        for (int tl = 0; tl < 5; ++tl)
#pragma unroll
            for (int r = 0; r < 16; ++r) { const int m = 32 * (i + tl) + (r & 3) + 8 * (r >> 2) + 4 * h; const int dist = 128 + t - m;
                const bool valid = (dist >= 0) && (dist < 128) && (nb > 0 || m >= 128);
                const float sv = valid ? S[tl][r] * 0.125f + BIAS[hh * 128 + (dist & 127)] : -1e30f; S[tl][r] = sv; mx = fmaxf(mx, sv); }
        mx = fmaxf(mx, __shfl_xor(mx, 32)); const float M = fmaxf(mx, sink); float sum = 0.f;
#pragma unroll
        for (int tl = 0; tl < 5; ++tl)
#pragma unroll
            for (int r = 0; r < 16; ++r) { const float p = __expf(S[tl][r] - M); S[tl][r] = p; sum += p; }
        sum += __shfl_xor(sum, 32); const float inv = frcp(sum + __expf(sink - M));
        f32x16 O[2];
#pragma unroll
        for (int e = 0; e < 16; ++e) { O[0][e] = 0.f; O[1][e] = 0.f; }
#pragma unroll
        for (int tl = 0; tl < 5; ++tl)
#pragma unroll
            for (int ss = 0; ss < 2; ++ss) {
                bf16x8 pf; { const unsigned w0 = pk2(S[tl][8 * ss + 0], S[tl][8 * ss + 1]), w1 = pk2(S[tl][8 * ss + 2], S[tl][8 * ss + 3]), w2 = pk2(S[tl][8 * ss + 4], S[tl][8 * ss + 5]), w3 = pk2(S[tl][8 * ss + 6], S[tl][8 * ss + 7]);
                    pf = __builtin_bit_cast(bf16x8, (v4u){w0, w1, w2, w3}); }
#pragma unroll
                for (int dt = 0; dt < 2; ++dt) {
                    const LAS unsigned char* vp = VT + (32 * dt + q) * 520 + (32 * (i + tl) + 16 * ss + 4 * h) * 2;
                    const v2u lo = *(const LAS v2u*)vp, hi2 = *(const LAS v2u*)(vp + 16);
                    const bf16x8 vf = __builtin_bit_cast(bf16x8, (v4u){lo.x, lo.y, hi2.x, hi2.y});
                    O[dt] = __builtin_amdgcn_mfma_f32_32x32x16_bf16(vf, pf, O[dt], 0, 0, 0);
                }
            }
        bf16* orow = (bf16*)(F.ws + WS_CAT) + qrow * DM + 512 + head * 64;
#pragma unroll
        for (int dt = 0; dt < 2; ++dt)
#pragma unroll
            for (int rg = 0; rg < 4; ++rg) { v2u w; w.x = pk2(O[dt][4 * rg] * inv, O[dt][4 * rg + 1] * inv); w.y = pk2(O[dt][4 * rg + 2] * inv, O[dt][4 * rg + 3] * inv); *(v2u*)(orow + 32 * dt + 8 * rg + 4 * h) = w; }
    }
    __syncthreads();
}
constexpr int SWS_K = 0, SWS_V = 132 * 68 * 4, SWS_Q = SWS_V + 132 * 64 * 4, SWS_S = SWS_Q + 4096, SWS_BIAS = SWS_S + 8704;
__device__ __forceinline__ void swa_sample_unit(const Frame& F, int idx, int unit) {
    const int b = unit >> 1, kvh = unit & 1, tid = F.tid, lane = F.lane, wave = F.wave;
    LAS float* Ks = (LAS float*)(F.lds + SWS_K); LAS float* Vs = (LAS float*)(F.lds + SWS_V); LAS float* Qs = (LAS float*)(F.lds + SWS_Q); LAS float* Ss = (LAS float*)(F.lds + SWS_S); LAS float* BIAS = (LAS float*)(F.lds + SWS_BIAS);
    const bf16* PROJ = (const bf16*)(F.ws + WS_PROJ);
    for (int e = tid; e < 132 * 16; e += 512) {
        const int jk = e >> 4, d4 = (e & 15) * 4; f32x4 kv, vv;
        if (jk < 128) { const size_t co = (((size_t)(idx * DECB + b) * 128 + jk) * 2 + kvh) * 64 + d4; kv = *(const f32x4*)(F.in[I_CK] + co); vv = *(const f32x4*)(F.in[I_CV] + co); }
        else { const bf16* src = PROJ + (size_t)(TP + 4 * b + (jk - 128)) * EVEN_IN + 1024 + kvh * 64 + d4; const v2u kw = *(const v2u*)src, vw = *(const v2u*)(src + 128);
            kv = (f32x4){bflo(kw.x), bfhi(kw.x), bflo(kw.y), bfhi(kw.y)}; vv = (f32x4){bflo(vw.x), bfhi(vw.x), bflo(vw.y), bfhi(vw.y)}; }
        *(LAS f32x4*)(Ks + jk * 68 + d4) = kv; *(LAS f32x4*)(Vs + jk * 64 + d4) = vv;
        if (jk >= 4) { const size_t oo = (((size_t)(idx * DECB + b) * 128 + (jk - 4)) * 2 + kvh) * 64 + d4; *(f32x4*)(F.out + O_KS + oo) = kv; *(f32x4*)(F.out + O_VS + oo) = vv; }
    }
    for (int e = tid; e < 1024; e += 512) { const int rq = e >> 6, d = e & 63, i = rq >> 2, hh = rq & 3; Qs[e] = bf2f(PROJ[(size_t)(TP + 4 * b + i) * EVEN_IN + 512 + (kvh * 4 + hh) * 64 + d]); }
    { const int hh = tid >> 7, dist = tid & 127; BIAS[tid] = F.in[I_T5][t5_bucket(dist) * SWH + kvh * 4 + hh]; }
    __syncthreads();
    for (int pidx = tid; pidx < 16 * 132; pidx += 512) {
        const int rq = pidx / 132, jk = pidx - rq * 132, i = rq >> 2, hh = rq & 3; float dot = 0.f;
#pragma unroll
        for (int d4 = 0; d4 < 16; ++d4) { const f32x4 qv = *(const LAS f32x4*)(Qs + rq * 64 + d4 * 4), kv = *(const LAS f32x4*)(Ks + jk * 68 + d4 * 4); dot += (qv.x * kv.x + qv.y * kv.y) + (qv.z * kv.z + qv.w * kv.w); }
        const int dist = 128 + i - jk; const bool valid = dist >= 0 && dist < 128;
        Ss[rq * 136 + jk] = valid ? dot * 0.125f + BIAS[hh * 128 + (dist & 127)] : -1e30f;
    }
    __syncthreads();
#pragma unroll
    for (int rr = 0; rr < 2; ++rr) {
        const int rq = 2 * wave + rr, hh = rq & 3; const float sink = F.in[I_SINK][idx * SWH + kvh * 4 + hh];
        const float s0 = Ss[rq * 136 + lane], s1 = Ss[rq * 136 + 64 + lane], s2 = (lane < 4) ? Ss[rq * 136 + 128 + lane] : -1e30f;
        float mx = fmaxf(fmaxf(s0, s1), s2);
#pragma unroll
        for (int o = 1; o < 64; o <<= 1) mx = fmaxf(mx, __shfl_xor(mx, o));
        const float M = fmaxf(mx, sink); const float p0 = __expf(s0 - M), p1 = __expf(s1 - M), p2 = __expf(s2 - M);
        const float inv = 1.0f / (wave_sum(p0 + p1 + p2) + __expf(sink - M));
        Ss[rq * 136 + lane] = p0 * inv; Ss[rq * 136 + 64 + lane] = p1 * inv; if (lane < 4) Ss[rq * 136 + 128 + lane] = p2 * inv;
    }
    __syncthreads();
    if (tid < 256) {
        const int rq = tid >> 4, d4 = (tid & 15) * 4, i = rq >> 2, hh = rq & 3; f32x4 o = (f32x4){0.f, 0.f, 0.f, 0.f};
#pragma unroll 4
        for (int jk = 0; jk < 132; ++jk) o += *(const LAS f32x4*)(Vs + jk * 64 + d4) * Ss[rq * 136 + jk];
        v2u ow; ow.x = pk2(o.x, o.y); ow.y = pk2(o.z, o.w);
        *(v2u*)((bf16*)(F.ws + WS_CAT) + (size_t)(TP + 4 * b + i) * DM + 512 + (kvh * 4 + hh) * 64 + d4) = ow;
    }
    __syncthreads();
}
__device__ __forceinline__ float hgrn_lb(const Frame& F, int idx, int c) {
    if (idx == 0) return 0.f;
    const float p0 = F.in[I_LB][c], p1 = F.in[I_LB][1024 + c], m = fmaxf(p0, p1), e0 = expf(p0 - m), e1 = expf(p1 - m), s = e0 + e1, s0 = e0 / s, s1 = e1 / s;
    return (s0 + s1) - s0;
}
__device__ __forceinline__ void hgrn_gate(float z, float lb, float& logf_, float& kf) {
    z = fminf(fmaxf(z, -80.f), 80.f);
    const float ez = __expf(-z), sig = frcp(1.0f + ez);
    logf_ = __builtin_amdgcn_logf(fmaxf(lb, 1e-30f) + (1.0f - lb) * sig) * 0.69314718056f;
    kf = (1.0f - lb) * (ez * sig);
}
constexpr int HG_QI = 0, HG_KI = 17408, HG_KT = 34816, HG_VT = 53248, HG_SI = 71680, HG_RED = 106496, HG_NRM = 108544, HG_RV = 110592;
template <bool FULL>
__device__ __forceinline__ void hgrn_prompt_unit(const Frame& F, int idx, int unit) {
    const int bh = unit / NSC, sc = unit % NSC, b = bh >> 3, h = bh & 7;
    const int tid = F.tid, lane = F.lane, wave = F.wave, d = tid & 127, sq = tid >> 7, l31 = lane & 31, hl = lane >> 5;
    LAS unsigned char* L = F.lds;
    LAS float* RED = (LAS float*)(L + HG_RED); LAS float* NRM = (LAS float*)(L + HG_NRM);
    const bf16* PROJ = (const bf16*)(F.ws + WS_PROJ);
    const float lb = hgrn_lb(F, idx, h * 128 + d);
    const int vts = wave >> 1, dts0 = 2 * (wave & 1);
    const int tt = wave & 1, vt = wave >> 1;
    f32x16 Sacc[2];
    {
        const float* S0 = (const float*)(F.ws + WS_HS) + (size_t)unit * 16384;
#pragma unroll
        for (int k = 0; k < 2; ++k)
#pragma unroll
            for (int r = 0; r < 16; ++r) { const int v = 32 * vts + (r & 3) + 8 * (r >> 2) + 4 * hl, dd = 32 * (dts0 + k) + l31; Sacc[k][r] = (FULL && sc > 0) ? S0[v * 128 + dd] : 0.f; }
    }
    float sumbl = 0.f;
    const size_t rowbase = (size_t)b * SEQ + (size_t)sc * SCT;
    v4u pfz[2], pq[2], pv[2];
#define HG_ISSUE(chn) do { _Pragma("unroll") for (int i_ = 0; i_ < 2; ++i_) { const int p_ = tid + 512 * i_; const bf16* src_ = PROJ + (rowbase + (size_t)(chn) * HCH + (p_ >> 4)) * ODD_IN + h * 128 + (p_ & 15) * 8; \
        pfz[i_] = *(const v4u*)(src_ + 1024); if (FULL) pq[i_] = *(const v4u*)src_; pv[i_] = *(const v4u*)(src_ + 2048); } } while (0)
    HG_ISSUE(0);
    for (int ch = 0; ch < SCT / HCH; ++ch) {
        const size_t row0 = rowbase + (size_t)ch * HCH;
#pragma unroll
        for (int i = 0; i < 2; ++i) { const int p = tid + 512 * i, off = (p >> 4) * 272 + (p & 15) * 16;
            *(LAS v4u*)(L + HG_KI + off) = pfz[i]; if (FULL) *(LAS v4u*)(L + HG_QI + off) = pq[i]; *(LAS v4u*)(L + HG_RV + off) = pv[i]; }
        __syncthreads();
        if (ch + 1 < SCT / HCH) HG_ISSUE(ch + 1);
        float cum[16], kf[16]; float run = 0.f;
#pragma unroll
        for (int e = 0; e < 16; ++e) { float lf; hgrn_gate(bf2f(*(const LAS bf16*)(L + HG_KI + (sq * 16 + e) * 272 + d * 2)), lb, lf, kf[e]); run += lf; cum[e] = run; }
        RED[sq * 128 + d] = run;
        __syncthreads();
        {
            const float r0 = RED[d], r1 = RED[128 + d], r2 = RED[256 + d], r3 = RED[384 + d];
            const float off = (sq > 0 ? r0 : 0.f) + (sq > 1 ? r1 : 0.f) + (sq > 2 ? r2 : 0.f), bmid = r0 + r1;
            if (sq == 0) sumbl += (r0 + r1) + (r2 + r3);
            unsigned kw[8], vw[8];
#pragma unroll
            for (int e = 0; e < 16; e += 2) {
                const float bt0 = off + cum[e], bt1 = off + cum[e + 1];
                kw[e >> 1] = pk2(kf[e] * __expf(bmid - bt0), kf[e + 1] * __expf(bmid - bt1));
                LAS bf16* k0p = (LAS bf16*)(L + HG_KI + (sq * 16 + e) * 272 + d * 2); LAS bf16* k1p = (LAS bf16*)(L + HG_KI + (sq * 16 + e + 1) * 272 + d * 2);
                if (FULL) {
                    k0p[0] = (bf16)(kw[e >> 1] & 0xffffu); k1p[0] = (bf16)(kw[e >> 1] >> 16);
                    LAS bf16* q0p = (LAS bf16*)(L + HG_QI + (sq * 16 + e) * 272 + d * 2); LAS bf16* q1p = (LAS bf16*)(L + HG_QI + (sq * 16 + e + 1) * 272 + d * 2);
                    const float q0 = bf2f(q0p[0]), q1 = bf2f(q1p[0]);
                    { const unsigned qw = pk2(fsilu(q0) * __expf(bt0 - bmid), fsilu(q1) * __expf(bt1 - bmid)); q0p[0] = (bf16)(qw & 0xffffu); q1p[0] = (bf16)(qw >> 16); }
                }
                vw[e >> 1] = (unsigned)(*(const LAS bf16*)(L + HG_RV + (sq * 16 + e) * 272 + d * 2)) | ((unsigned)(*(const LAS bf16*)(L + HG_RV + (sq * 16 + e + 1) * 272 + d * 2)) << 16);
            }
            *(LAS v4u*)(L + HG_KT + d * 144 + sq * 32) = (v4u){kw[0], kw[1], kw[2], kw[3]}; *(LAS v4u*)(L + HG_KT + d * 144 + sq * 32 + 16) = (v4u){kw[4], kw[5], kw[6], kw[7]};
            *(LAS v4u*)(L + HG_VT + d * 144 + sq * 32) = (v4u){vw[0], vw[1], vw[2], vw[3]}; *(LAS v4u*)(L + HG_VT + d * 144 + sq * 32 + 16) = (v4u){vw[4], vw[5], vw[6], vw[7]};
        }
        if (FULL) {
#pragma unroll
            for (int k = 0; k < 2; ++k) { const int dd = 32 * (dts0 + k) + l31; const float em = __expf(RED[dd] + RED[128 + dd]);
#pragma unroll
                for (int r = 0; r < 16; r += 2) { const int v = 32 * vts + (r & 3) + 8 * (r >> 2) + 4 * hl; const unsigned w = pk2(Sacc[k][r] * em, Sacc[k][r + 1] * em);
                    *(LAS bf16*)(L + HG_SI + v * 272 + dd * 2) = (bf16)(w & 0xffffu); *(LAS bf16*)(L + HG_SI + (v + 1) * 272 + dd * 2) = (bf16)(w >> 16); } }
        }
        __syncthreads();
        f32x16 O;
        if (FULL) {
            f32x16 X[2];
#pragma unroll
            for (int st = 0; st < 2; ++st) {
#pragma unroll
                for (int e = 0; e < 16; ++e) X[st][e] = 0.f;
                if (st <= tt) {
#pragma unroll
                    for (int ks = 0; ks < 8; ++ks) { const bf16x8 a = *(const LAS bf16x8*)(L + HG_KI + (32 * st + l31) * 272 + (16 * ks + 8 * hl) * 2), bq = *(const LAS bf16x8*)(L + HG_QI + (32 * tt + l31) * 272 + (16 * ks + 8 * hl) * 2);
                        X[st] = __builtin_amdgcn_mfma_f32_32x32x16_bf16(a, bq, X[st], 0, 0, 0); }
#pragma unroll
                    for (int r = 0; r < 16; ++r) { const int s = 32 * st + (r & 3) + 8 * (r >> 2) + 4 * hl, t = 32 * tt + l31; if (s > t) X[st][r] = 0.f; }
                }
            }
#pragma unroll
            for (int e = 0; e < 16; ++e) O[e] = 0.f;
#pragma unroll
            for (int st = 0; st < 2; ++st)
                if (st <= tt) {
#pragma unroll
                    for (int ss = 0; ss < 2; ++ss) {
                        const bf16x8 pf = __builtin_bit_cast(bf16x8, (v4u){pk2(X[st][8 * ss], X[st][8 * ss + 1]), pk2(X[st][8 * ss + 2], X[st][8 * ss + 3]), pk2(X[st][8 * ss + 4], X[st][8 * ss + 5]), pk2(X[st][8 * ss + 6], X[st][8 * ss + 7])});
                        const LAS unsigned char* vp = L + HG_VT + (32 * vt + l31) * 144 + (32 * st + 16 * ss + 4 * hl) * 2;
                        const v2u lo = *(const LAS v2u*)vp, hi2 = *(const LAS v2u*)(vp + 16);
                        O = __builtin_amdgcn_mfma_f32_32x32x16_bf16(__builtin_bit_cast(bf16x8, (v4u){lo.x, lo.y, hi2.x, hi2.y}), pf, O, 0, 0, 0);
                    }
                }
#pragma unroll
            for (int ks = 0; ks < 8; ++ks) { const bf16x8 a = *(const LAS bf16x8*)(L + HG_SI + (32 * vt + l31) * 272 + (16 * ks + 8 * hl) * 2), bq = *(const LAS bf16x8*)(L + HG_QI + (32 * tt + l31) * 272 + (16 * ks + 8 * hl) * 2);
                O = __builtin_amdgcn_mfma_f32_32x32x16_bf16(a, bq, O, 0, 0, 0); }
        }
#pragma unroll
        for (int k = 0; k < 2; ++k) {
            f32x16 Dl;
#pragma unroll
            for (int e = 0; e < 16; ++e) Dl[e] = 0.f;
            const int dd = 32 * (dts0 + k) + l31;
#pragma unroll
            for (int ks = 0; ks < 4; ++ks) { const bf16x8 a = *(const LAS bf16x8*)(L + HG_VT + (32 * vts + l31) * 144 + (16 * ks + 8 * hl) * 2), bk = *(const LAS bf16x8*)(L + HG_KT + dd * 144 + (16 * ks + 8 * hl) * 2);
                Dl = __builtin_amdgcn_mfma_f32_32x32x16_bf16(a, bk, Dl, 0, 0, 0); }
            const float hi_ = RED[256 + dd] + RED[384 + dd], el = __expf((RED[dd] + RED[128 + dd]) + hi_), ed = __expf(hi_);
#pragma unroll
            for (int r = 0; r < 16; ++r) Sacc[k][r] = Sacc[k][r] * el + Dl[r] * ed;
        }
        if (FULL) {
            float ssq = 0.f;
#pragma unroll
            for (int r = 0; r < 16; ++r) ssq += O[r] * O[r];
            ssq += __shfl_xor(ssq, 32);
            if (hl == 0) NRM[vt * 64 + 32 * tt + l31] = ssq;
            __syncthreads();
            const int t = 32 * tt + l31; const float tot = (NRM[t] + NRM[64 + t]) + (NRM[128 + t] + NRM[192 + t]);
            const float rstd = __builtin_amdgcn_rsqf(tot * (1.0f / HDV) + RMS_EPS);
            const size_t row = row0 + t;
#pragma unroll
            for (int rg = 0; rg < 4; ++rg) { const int v0 = 32 * vt + 8 * rg + 4 * hl;
                const v2u gw = *(const v2u*)(PROJ + row * ODD_IN + 3072 + h * 128 + v0); const f32x4 gn = *(const f32x4*)(F.in[I_GN] + idx * HDV + v0);
                const float g0 = bflo(gw.x), g1 = bfhi(gw.x), g2 = bflo(gw.y), g3 = bfhi(gw.y);
                const float o0 = O[4 * rg] * rstd * gn[0] * fsilu(g0), o1 = O[4 * rg + 1] * rstd * gn[1] * fsilu(g1), o2 = O[4 * rg + 2] * rstd * gn[2] * fsilu(g2), o3 = O[4 * rg + 3] * rstd * gn[3] * fsilu(g3);
                v2u ow; ow.x = pk2(o0, o1); ow.y = pk2(o2, o3); *(v2u*)((bf16*)(F.ws + WS_CAT) + row * DM + h * 128 + v0) = ow; }
        } else {
            __syncthreads();
        }
    }
#undef HG_ISSUE
    if (!FULL) {
        float* U = (float*)(F.ws + WS_HU) + (size_t)unit * 16384;
#pragma unroll
        for (int k = 0; k < 2; ++k)
#pragma unroll
            for (int r = 0; r < 16; ++r) { const int v = 32 * vts + (r & 3) + 8 * (r >> 2) + 4 * hl, dd = 32 * (dts0 + k) + l31; U[v * 128 + dd] = Sacc[k][r]; }
        if (sq == 0) ((float*)(F.ws + WS_HD))[(size_t)unit * 128 + d] = sumbl;
    }
    __syncthreads();
}
__device__ __forceinline__ void hgrn_carry_phase(const Frame& F, int idx) {
    const float* U = (const float*)(F.ws + WS_HU); float* HSs = (float*)(F.ws + WS_HS); const float* HD = (const float*)(F.ws + WS_HD);
    for (int e = F.vcu * 512 + F.tid; e < 16 * 16384; e += F.G * 512) {
        const int bh = e >> 14, vd = e & 16383, v = vd >> 7, dd = vd & 127; float S = 0.f;
        for (int sc = 0; sc < NSC; ++sc) { const size_t u = (size_t)(bh * NSC + sc); HSs[u * 16384 + vd] = S; S = __expf(HD[u * 128 + dd]) * S + U[u * 16384 + vd]; }
        F.out[O_HP + ((size_t)(idx * 16 + bh) * 128 + dd) * 128 + v] = S;
    }
}
constexpr int HS_QH = 0, HS_KH = 2048, HS_EL = 4096, HS_V = 4608, HS_SC = 6656, HS_NR = 6784, HS_OP = 8192;
__device__ __forceinline__ void hgrn_sample_unit(const Frame& F, int idx, int unit) {
    const int b = unit >> 3, h = unit & 7, tid = F.tid, lane = F.lane, wave = F.wave;
    LAS float* QH = (LAS float*)(F.lds + HS_QH); LAS float* KH = (LAS float*)(F.lds + HS_KH); LAS float* EL = (LAS float*)(F.lds + HS_EL); LAS float* Vs = (LAS float*)(F.lds + HS_V);
    LAS float* SC = (LAS float*)(F.lds + HS_SC); LAS float* NR = (LAS float*)(F.lds + HS_NR); LAS float* OP = (LAS float*)(F.lds + HS_OP);
    const bf16* PROJ = (const bf16*)(F.ws + WS_PROJ); const size_t row0 = (size_t)TP + 4 * b;
    const int vq = tid & 31, dg = tid >> 5; const size_t so = ((size_t)(idx * DECB + b) * HH + h) * 16384;
    const float* S0 = F.in[I_SH] + so; float* SN = F.out + O_HS + so;
    f32x4 s4r[8];
#pragma unroll
    for (int i = 0; i < 8; ++i) s4r[i] = __builtin_nontemporal_load((const f32x4*)(S0 + (dg * 8 + i) * 128 + 4 * vq));
    if (tid < 128) {
        const int d = tid; const float lb = hgrn_lb(F, idx, h * 128 + d);
        float bt[4], kf[4], qf[4]; float run = 0.f;
#pragma unroll
        for (int t = 0; t < 4; ++t) { const bf16* pr = PROJ + (row0 + t) * ODD_IN + h * 128 + d; float lf; hgrn_gate(bf2f(pr[1024]), lb, lf, kf[t]); run += lf; bt[t] = run; const float qq = bf2f(pr[0]); qf[t] = fsilu(qq); Vs[t * 128 + d] = bf2f(pr[2048]); }
#pragma unroll
        for (int t = 0; t < 4; ++t) { QH[t * 128 + d] = qf[t] * __expf(bt[t]); KH[t * 128 + d] = kf[t] * __expf(bt[3] - bt[t]); }
        EL[d] = __expf(bt[3]);
#pragma unroll
        for (int t = 0; t < 4; ++t)
#pragma unroll
            for (int s = 0; s < 4; ++s) if (s <= t) { const float ws = wave_sum(qf[t] * kf[s] * __expf(bt[t] - bt[s])); if (lane == 0) SC[wave * 16 + t * 4 + s] = ws; }
    }
    __syncthreads();
    {
        f32x4 op[4];
#pragma unroll
        for (int t = 0; t < 4; ++t) op[t] = (f32x4){0.f, 0.f, 0.f, 0.f};
        f32x4 v4[4];
#pragma unroll
        for (int s = 0; s < 4; ++s) v4[s] = *(const LAS f32x4*)(Vs + s * 128 + 4 * vq);
#pragma unroll
        for (int i = 0; i < 8; ++i) {
            const int dd = dg * 8 + i; const f32x4 s4 = s4r[i];
            f32x4 sn = s4 * EL[dd];
#pragma unroll
            for (int s = 0; s < 4; ++s) sn += v4[s] * KH[s * 128 + dd];
            __builtin_nontemporal_store(sn, (f32x4*)(SN + dd * 128 + 4 * vq));
#pragma unroll
            for (int t = 0; t < 4; ++t) op[t] += s4 * QH[t * 128 + dd];
        }
#pragma unroll
        for (int t = 0; t < 4; ++t) *(LAS f32x4*)(OP + (dg * 4 + t) * 128 + 4 * vq) = op[t];
    }
    __syncthreads();
    {
        const int t = tid >> 7, v = tid & 127; float o = 0.f;
#pragma unroll
        for (int dg = 0; dg < 16; ++dg) o += OP[(dg * 4 + t) * 128 + v];
#pragma unroll
        for (int s = 0; s < 4; ++s) if (s <= t) o += (SC[t * 4 + s] + SC[16 + t * 4 + s]) * Vs[s * 128 + v];
        const float ss = wave_sum(o * o); if (lane == 0) NR[wave] = ss;
        __syncthreads();
        const float tot = NR[2 * t] + NR[2 * t + 1]; const float rstd = 1.0f / sqrtf(tot * (1.0f / HDV) + RMS_EPS);
        const float gz = bf2f(PROJ[(row0 + t) * ODD_IN + 3072 + h * 128 + v]);
        ((bf16*)(F.ws + WS_CAT))[(row0 + t) * DM + h * 128 + v] = (bf16)f2bf(o * rstd * F.in[I_GN][idx * HDV + v] * fsilu(gz));
    }
    __syncthreads();
}
constexpr int N_PHASES = 37;
#ifndef MK_ONE_LAUNCH
#define MK_ONE_LAUNCH 1
#endif

template <class Epi> __device__ __forceinline__ void run_gemm(const Frame& F, const bf16* A, const bf16* Bt, int N, int K, const Epi& E) {
    pg8::Gemm g{A, Bt, MT, N, K}; pg8::StaticOrder S; S.init(MT, N, K, F.G, (int)blockIdx.x);
    pg8::gemm_phase<Epi, pg8::StaticOrder, true, true>(F.lds, g, S, E);
}
__device__ __forceinline__ void run_gemm_split(const Frame& F, const bf16* A, const bf16* Bt, int K, int S_) {
    pg8::Gemm g{A, Bt, MT, DM, K}; pg8::SplitOrder S; S.init(K, S_, F.G, (int)blockIdx.x);
    pg8::gemm_phase<pg8::EpiF32Split, pg8::SplitOrder, true, true>(F.lds, g, S, pg8::EpiF32Split{(float*)(F.ws + WS_MIX), DM, (float*)(F.ws + WS_SLAB)});
}


#define PH_BAR() do { if (cur + 1 < hi) xcd_barrier(bar); } while (0)
#ifndef REP_MASK
#define REP_MASK 0u
#endif
#define PHASE_C(cls, body) do { if (lo <= cur && cur < hi) { { int t_ = threadIdx.x; asm volatile("" : "+v"(t_)); F.tid = t_; F.lane = t_ & 63; F.wave = __builtin_amdgcn_readfirstlane(t_ >> 6); } body; \
        if ((cls) >= 0 && ((REP_MASK >> ((cls) & 31)) & 1u)) { __syncthreads(); body; } PH_BAR(); } ++cur; } while (0)
#define PHASE(body) PHASE_C(-1, body)
#define REPQ(cls, stmt) do { stmt; if ((REP_MASK >> (cls)) & 1u) { __syncthreads(); stmt; } } while (0)

__global__ void __launch_bounds__(NWAVES * 64, 2) mega_fwd(Args args) {
    extern __shared__ __attribute__((aligned(16))) unsigned char lds[];
    Frame F;
    F.lds = (LAS unsigned char*)lds; F.in = args.in; F.out = args.out; F.ws = args.ws;
    F.tid = threadIdx.x; F.lane = F.tid & 63; F.wave = __builtin_amdgcn_readfirstlane(F.tid >> 6);
    F.G = gridDim.x; { const int bx = blockIdx.x; F.vcu = (F.G % 8 == 0) ? (bx % 8) * (F.G / 8) + bx / 8 : bx; }
    volatile LAS unsigned* MISC = (volatile LAS unsigned*)(F.lds + MISC_OFF);
    for (int u = F.tid; u < (LDS_BYTES - RING_BYTES) / 4; u += NWAVES * 64) ((LAS unsigned*)(F.lds + RING_BYTES))[u] = 0u;
    __syncthreads();
    const int lo = args.ph_lo, hi = args.ph_hi;
    XcdBarrier bar; bar.bar = (unsigned*)(args.ws + WS_CTL) + CW_BAR; bar.x = 0; bar.st = nullptr;
    if (hi - lo > 1) bar = xcd_barrier_post((unsigned*)(args.ws + WS_CTL) + CW_BAR, MISC + 8);
    bf16* const XN = (bf16*)(F.ws + WS_XN); bf16* const CAT = (bf16*)(F.ws + WS_CAT); bf16* const G = (bf16*)(F.ws + WS_G); bf16* const PROJ = (bf16*)(F.ws + WS_PROJ); float* const MIX = (float*)(F.ws + WS_MIX);
    int cur = 0;
    PHASE_C(0, p0_prologue(F));
#pragma unroll 1
    for (int idx = 0; idx < 2; ++idx) {
        { const int l = 2 * idx;
        PHASE_C(1, run_gemm(F, XN, (const bf16*)(F.ws + WS_WINE) + (size_t)idx * EVEN_IN * DM, EVEN_IN, DM, pg8::EpiBf16<0>{PROJ, EVEN_IN}));
        PHASE_C(2, { REPQ(8, for (int u = F.vcu; u < 256; u += F.G) swa_prompt_unit(F, idx, u));
                REPQ(9, for (int u = F.vcu; u < 256; u += F.G) swa_sample_unit(F, idx, u));
                REPQ(10, for (int u = F.vcu * NWAVES + F.wave; u < 2048; u += F.G * NWAVES) s5_unit<0>(F, idx, u & 31, u >> 5, F.lds + F.wave * 8704)); });
        PHASE_C(3, { REPQ(11, for (int u = F.vcu * NWAVES + F.wave; u < 2048; u += F.G * NWAVES) s5_unit<1>(F, idx, u & 31, u >> 5, F.lds + F.wave * 8704));
                REPQ(12, for (int u = F.vcu * NWAVES + F.wave; u < 512; u += F.G * NWAVES) s5_unit<2>(F, idx, u & 31, 0, F.lds + F.wave * 8704, u >> 5, (u >> 5) + 1)); });
        PHASE_C(17, run_gemm(F, G, (const bf16*)(F.ws + WS_WGLU) + (size_t)idx * S5W * S5W, S5W, S5W, pg8::EpiGlu{G, S5W, CAT, DM}));
        PHASE_C(5, run_gemm_split(F, CAT, (const bf16*)(F.ws + WS_WOUTE) + (size_t)idx * DM * DM, DM, 4));
        PHASE(norm_res_phase(F, F.in[I_NMIXPOST] + l * DM, F.in[I_NMLPPRE] + l * DM, 4));
        PHASE_C(6, run_gemm(F, XN, (const bf16*)(F.ws + WS_WUP) + (size_t)l * DFF * DM, DFF, DM, pg8::EpiBf16<2>{PROJ, DFF}));
        PHASE_C(7, run_gemm_split(F, PROJ, (const bf16*)(F.ws + WS_WDN) + (size_t)l * DM * DFF, DFF, 16));
        PHASE(norm_res_phase(F, F.in[I_NMLPPOST] + l * DM, F.in[I_NMIXPRE] + (l + 1) * DM, 16)); }
        { const int l = 2 * idx + 1;
        PHASE_C(1, run_gemm(F, XN, (const bf16*)(F.ws + WS_WINO) + (size_t)idx * ODD_IN * DM, ODD_IN, DM, pg8::EpiBf16<0>{PROJ, ODD_IN}));
        PHASE_C(2, { REPQ(13, for (int u = F.vcu; u < 16 * NSC; u += F.G) hgrn_prompt_unit<false>(F, idx, u));
                REPQ(14, for (int u = F.vcu; u < DECB * HH; u += F.G) hgrn_sample_unit(F, idx, u)); });
        PHASE_C(15, hgrn_carry_phase(F, idx));
        PHASE_C(16, { for (int u = F.vcu; u < 16 * NSC; u += F.G) hgrn_prompt_unit<true>(F, idx, u); });
        PHASE_C(5, run_gemm_split(F, CAT, (const bf16*)(F.ws + WS_WOUTO) + (size_t)idx * DM * DM, DM, 4));
        PHASE(norm_res_phase(F, F.in[I_NMIXPOST] + l * DM, F.in[I_NMLPPRE] + l * DM, 4));
        PHASE_C(6, run_gemm(F, XN, (const bf16*)(F.ws + WS_WUP) + (size_t)l * DFF * DM, DFF, DM, pg8::EpiBf16<2>{PROJ, DFF}));
        PHASE_C(7, run_gemm_split(F, PROJ, (const bf16*)(F.ws + WS_WDN) + (size_t)l * DM * DFF, DFF, 16));
        PHASE(norm_res_phase(F, F.in[I_NMLPPOST] + l * DM, (l < 3) ? F.in[I_NMIXPRE] + (l + 1) * DM : nullptr, 16)); }
    }
}

extern "C" void kernel_launch(void* const* d_in, const int* in_sizes, int n_in, void* d_out, int out_size, void* d_ws, size_t ws_size, hipStream_t stream) {
    static int grid = 0;
    if (grid == 0) {
        if (n_in != N_IN || (size_t)out_size != O_END || ws_size < WS_END) { fprintf(stderr, "kernel_launch: unexpected problem (n_in %d, out %d, ws %zu); nothing launched\n", n_in, out_size, ws_size); grid = -1; return; }
        int dev = 0, cus = 0, per_cu = 0;
        if (hipGetDevice(&dev) != hipSuccess || hipDeviceGetAttribute(&cus, hipDeviceAttributeMultiprocessorCount, dev) != hipSuccess) { grid = -1; return; }
        if (hipFuncSetAttribute((const void*)mega_fwd, hipFuncAttributeMaxDynamicSharedMemorySize, LDS_BYTES) != hipSuccess) { fprintf(stderr, "kernel_launch: hipFuncSetAttribute failed\n"); grid = -1; return; }
        if (hipOccupancyMaxActiveBlocksPerMultiprocessor(&per_cu, (const void*)mega_fwd, NWAVES * 64, LDS_BYTES) != hipSuccess || per_cu < 1) { fprintf(stderr, "kernel_launch: occupancy query says %d blocks per CU\n", per_cu); }
        (void)hipGetLastError();
        grid = cus;
    }
    if (grid < 0) return;
    if (hipMemsetAsync((char*)d_ws + WS_CTL, 0, CTL_ZERO_BYTES, stream) != hipSuccess) { fprintf(stderr, "kernel_launch: memset failed\n"); return; }
    Args a{};
    for (int i = 0; i < N_IN; ++i) a.in[i] = (const float*)d_in[i];
    a.out = (float*)d_out; a.ws = (unsigned char*)d_ws;
#if MK_ONE_LAUNCH
    a.ph_lo = 0; a.ph_hi = N_PHASES;
    hipLaunchKernelGGL(mega_fwd, dim3(grid), dim3(NWAVES * 64), LDS_BYTES, stream, a);
#else
    for (int ph = 0; ph < N_PHASES; ++ph) { a.ph_lo = ph; a.ph_hi = ph + 1; hipLaunchKernelGGL(mega_fwd, dim3(grid), dim3(NWAVES * 64), LDS_BYTES, stream, a); }
#endif
    const hipError_t le = hipPeekAtLastError();
    if (le != hipSuccess) fprintf(stderr, "kernel_launch: launch failed: %s\n", hipGetErrorName(le));
}
```
